# Optimizing an MI355X kernel written in HIP

```python
import math
import jax, jax.numpy as jnp
from jax import lax
import numpy as np

D_MODEL = 2048
BATCH = 4
SEQ = 2048
DEPTH = 4

RG_WIDTH = D_MODEL // 2
RG_BLOCKS = 16
RG_BLOCK_DIM = RG_WIDTH // RG_BLOCKS
RG_CONV = 4
RG_C = 8.0
ATTN_HEADS = 8
ATTN_HEAD_DIM = 64
ATTN_V_DIM = 2 * ATTN_HEAD_DIM
ATTN_QK_WIDTH = ATTN_HEADS * 2 * ATTN_HEAD_DIM
ATTN_WIDTH = ATTN_HEADS * ATTN_V_DIM
MIX_WIDTH = RG_WIDTH + ATTN_WIDTH
IN_WIDTH = 2 * RG_WIDTH + 2 * ATTN_QK_WIDTH + ATTN_WIDTH
IN_SPLITS = (RG_WIDTH, 2 * RG_WIDTH, 2 * RG_WIDTH + ATTN_QK_WIDTH, 2 * RG_WIDTH + 2 * ATTN_QK_WIDTH)
D_FF = 5632
FFN_CONV = 3
Q_BLOCK = 128
DEEPNORM_ALPHA = (2.0 * DEPTH) ** 0.25
DEEPNORM_BETA = (8.0 * DEPTH) ** -0.25
LN_EPS = 1e-5
RMS_EPS = 1e-5

kernel_name = "hymba_rglru_diffattn_alibi_convffn_deepnorm"


def _layernorm(x, g, b):
    xf = x.astype(jnp.float32)
    mu = jnp.mean(xf, axis=-1, keepdims=True)
    var = jnp.mean(jnp.square(xf - mu), axis=-1, keepdims=True)
    y = (xf - mu) * lax.rsqrt(var + LN_EPS) * g.astype(jnp.float32) + b.astype(jnp.float32)
    return y.astype(x.dtype)


def _causal_dwconv(x, w, b):
    K = w.shape[0]
    S = x.shape[1]
    xp = jnp.pad(x, ((0, 0), (K - 1, 0), (0, 0)))
    out = xp[:, 0:S] * w[0]
    for k in range(1, K):
        out = out + xp[:, k:k + S] * w[k]
    return out + b


def _lru_combine(left, right):
    a_l, b_l = left
    a_r, b_r = right
    return a_l * a_r, a_r * b_l + b_r


def _rglru_group(rg_x, rg_gate, conv_w, conv_b, wa, ba, wx, bx, lam):
    B, S, _ = rg_x.shape
    u = _causal_dwconv(rg_x, conv_w, conv_b)
    ub = u.reshape(B, S, RG_BLOCKS, RG_BLOCK_DIM)
    r = jax.nn.sigmoid(jnp.einsum('bsgi,gij->bsgj', ub, wa).reshape(B, S, RG_WIDTH) + ba)
    ig = jax.nn.sigmoid(jnp.einsum('bsgi,gij->bsgj', ub, wx).reshape(B, S, RG_WIDTH) + bx)
    log_a = RG_C * r.astype(jnp.float32) * jax.nn.log_sigmoid(lam.astype(jnp.float32))
    a = jnp.exp(log_a)
    mult = jnp.sqrt(-jnp.expm1(2.0 * log_a))
    bterm = mult * (ig * u).astype(jnp.float32)
    _, h = lax.associative_scan(_lru_combine, (a, bterm), axis=1)
    return h.astype(rg_x.dtype) * jax.nn.gelu(rg_gate)


def _diff_attn_group(q, k, v, layer_idx, lq1, lk1, lq2, lk2, subln_g):
    B, S, _ = q.shape
    H, d, V = ATTN_HEADS, ATTN_HEAD_DIM, ATTN_V_DIM
    kh = k.reshape(B, S, H, 2, d)
    vh = v.reshape(B, S, H, V)
    lam_init = 0.8 - 0.6 * math.exp(-0.3 * layer_idx)
    lam = (jnp.exp(jnp.sum(lq1.astype(jnp.float32) * lk1.astype(jnp.float32)))
           - jnp.exp(jnp.sum(lq2.astype(jnp.float32) * lk2.astype(jnp.float32))) + lam_init)
    slopes = jnp.exp2(-8.0 * jnp.arange(1, H + 1, dtype=jnp.float32) / H)
    scale = d ** -0.5
    nb = S // Q_BLOCK
    qb = q.reshape(B, nb, Q_BLOCK, H, 2, d).transpose(1, 0, 2, 3, 4, 5)
    starts = jnp.arange(nb, dtype=jnp.int32) * Q_BLOCK
    kpos = jnp.arange(S, dtype=jnp.int32)
    neg = jnp.finfo(jnp.float32).min

    def block(args):
        q_blk, start = args
        qpos = start + jnp.arange(Q_BLOCK, dtype=jnp.int32)
        dist = qpos[:, None] - kpos[None, :]
        bias = -slopes[:, None, None] * dist.astype(jnp.float32)[None]
        bias = jnp.where((dist >= 0)[None], bias, neg)
        s = jnp.einsum('bqhcd,bkhcd->bhcqk', q_blk, kh,
                       preferred_element_type=jnp.float32) * scale + bias[None, :, None]
        p = jax.nn.softmax(s, axis=-1)
        wgt = p[:, :, 0] - lam * p[:, :, 1]
        return jnp.einsum('bhqk,bkhv->bqhv', wgt.astype(vh.dtype), vh)

    o = lax.map(block, (qb, starts))
    o = o.transpose(1, 0, 2, 3, 4).reshape(B, S, H, V)
    of = o.astype(jnp.float32)
    of = of * lax.rsqrt(jnp.mean(jnp.square(of), axis=-1, keepdims=True) + RMS_EPS)
    of = of * subln_g.astype(jnp.float32) * (1.0 - lam_init)
    return of.astype(q.dtype).reshape(B, S, ATTN_WIDTH)


def setup_inputs(seed: int = 0) -> dict:
    key = jax.random.key(seed)
    ks = jax.random.split(key, 24)
    f32 = jnp.float32
    nrm = lambda k, shape, s: jax.random.normal(k, shape, f32) * s
    a0 = jax.random.uniform(ks[9], (DEPTH, RG_WIDTH), f32, minval=0.9, maxval=0.999)
    return {
        "x": jax.random.normal(ks[0], (BATCH, SEQ, D_MODEL), f32),
        "w_in": nrm(ks[1], (DEPTH, D_MODEL, IN_WIDTH), D_MODEL ** -0.5),
        "rg_conv_w": nrm(ks[2], (DEPTH, RG_CONV, RG_WIDTH), RG_CONV ** -0.5),
        "rg_conv_b": nrm(ks[3], (DEPTH, RG_WIDTH), 0.01),
        "rg_gate_a_w": nrm(ks[4], (DEPTH, RG_BLOCKS, RG_BLOCK_DIM, RG_BLOCK_DIM), RG_BLOCK_DIM ** -0.5),
        "rg_gate_a_b": nrm(ks[5], (DEPTH, RG_WIDTH), 0.01),
        "rg_gate_x_w": nrm(ks[6], (DEPTH, RG_BLOCKS, RG_BLOCK_DIM, RG_BLOCK_DIM), RG_BLOCK_DIM ** -0.5),
        "rg_gate_x_b": nrm(ks[7], (DEPTH, RG_WIDTH), 0.01),
        "rg_lambda": jnp.log(a0) - jnp.log1p(-a0),
        "lam_q1": nrm(ks[10], (DEPTH, ATTN_HEAD_DIM), 0.1),
        "lam_k1": nrm(ks[11], (DEPTH, ATTN_HEAD_DIM), 0.1),
        "lam_q2": nrm(ks[12], (DEPTH, ATTN_HEAD_DIM), 0.1),
        "lam_k2": nrm(ks[13], (DEPTH, ATTN_HEAD_DIM), 0.1),
        "subln_g": 1.0 + nrm(ks[14], (DEPTH, ATTN_V_DIM), 0.02),
        "w_out": nrm(ks[15], (DEPTH, MIX_WIDTH, D_MODEL), MIX_WIDTH ** -0.5 * DEEPNORM_BETA),
        "ln_mix_g": 1.0 + nrm(ks[16], (DEPTH, D_MODEL), 0.02),
        "ln_mix_b": nrm(ks[17], (DEPTH, D_MODEL), 0.02),
        "w_up": nrm(ks[18], (DEPTH, D_MODEL, 2 * D_FF), D_MODEL ** -0.5),
        "ffn_conv_w": nrm(ks[19], (DEPTH, FFN_CONV, 2 * D_FF), FFN_CONV ** -0.5),
        "ffn_conv_b": nrm(ks[20], (DEPTH, 2 * D_FF), 0.01),
        "w_down": nrm(ks[21], (DEPTH, D_FF, D_MODEL), D_FF ** -0.5 * DEEPNORM_BETA),
        "ln_ffn_g": 1.0 + nrm(ks[22], (DEPTH, D_MODEL), 0.02),
        "ln_ffn_b": nrm(ks[23], (DEPTH, D_MODEL), 0.02),
    }


def reference(x, w_in, rg_conv_w, rg_conv_b, rg_gate_a_w, rg_gate_a_b, rg_gate_x_w, rg_gate_x_b,
              rg_lambda, lam_q1, lam_k1, lam_q2, lam_k2, subln_g, w_out, ln_mix_g, ln_mix_b,
              w_up, ffn_conv_w, ffn_conv_b, w_down, ln_ffn_g, ln_ffn_b):
    for i in range(DEPTH):
        proj = jnp.einsum('bsd,de->bse', x, w_in[i])
        rg_x, rg_gate, q, k, v = jnp.split(proj, IN_SPLITS, axis=-1)
        rg_out = _rglru_group(rg_x, rg_gate, rg_conv_w[i], rg_conv_b[i], rg_gate_a_w[i],
                              rg_gate_a_b[i], rg_gate_x_w[i], rg_gate_x_b[i], rg_lambda[i])
        at_out = _diff_attn_group(q, k, v, i, lam_q1[i], lam_k1[i], lam_q2[i], lam_k2[i], subln_g[i])
        mix = jnp.einsum('bsm,md->bsd', jnp.concatenate([rg_out, at_out], axis=-1), w_out[i])
        x = _layernorm(DEEPNORM_ALPHA * x + mix, ln_mix_g[i], ln_mix_b[i])
        hu = _causal_dwconv(jnp.einsum('bsd,df->bsf', x, w_up[i]), ffn_conv_w[i], ffn_conv_b[i])
        g, u = jnp.split(hu, 2, axis=-1)
        ffn = jnp.einsum('bsf,fd->bsd', jax.nn.gelu(g) * u, w_down[i])
        x = _layernorm(DEEPNORM_ALPHA * x + ffn, ln_ffn_g[i], ln_ffn_b[i])
    return x
```

```cpp
#include <hip/hip_runtime.h>
#include <hip/hip_cooperative_groups.h>
#include <cstdio>
#include <cstdint>
namespace pg8 {
#define PG8_LAS __attribute__((address_space(3)))
typedef unsigned short bf16_t;
typedef short bf16x8 __attribute__((ext_vector_type(8)));
typedef float f32x4 __attribute__((ext_vector_type(4)));
typedef unsigned u32x4 __attribute__((ext_vector_type(4)));
constexpr int BM = 256, BK = 64, HALF = 128, HTB = HALF * BK * 2  , STAGE_BYTES = 8 * HTB, NXCD = 8, WGM = 8;

__host__ __device__ __forceinline__ int lds_byte(int r, int c) { const int st = (r >> 4) * 2 + (c >> 5), rr = r & 15, cc = c & 31, ob = rr * 64 + cc * 2; return st * 1024 + (ob ^ (((ob >> 9) & 1) << 5)); }
__host__ __device__ __forceinline__ void stage_rc(int b, int& R, int& C) { const int st = b / 1024, sb = b % 1024, swz = sb ^ (((sb >> 9) & 1) << 5); R = (st >> 1) * 16 + swz / 64; C = (st & 1) * 32 + (swz % 64) / 2; }
__host__ __device__ __forceinline__ int perm32(int rho) { const int n = rho >> 4, i = rho & 15; return 8 * (i >> 2) + 4 * n + (i & 3); }

struct Unit { int pm, pn; };
struct Gemm { const bf16_t* A; const bf16_t* Bt; int M, N, K; };

struct StaticOrder {
    int nM, nN, nwg, G, c;
    __host__ __device__ void init(int M, int N, int G_, int c_) { nM = M / BM; nN = N / BM; nwg = nM * nN; G = G_; c = c_; }
    __host__ __device__ bool next(int i, Unit& u) const {
        const long L = (long)i * G + c; if (L >= nwg) return false;
        int wgid = (int)L; { const int q = nwg / NXCD, r = nwg % NXCD, xcd = wgid % NXCD, off = wgid / NXCD; wgid = (xcd < r ? xcd * (q + 1) : r * (q + 1) + (xcd - r) * q) + off; }
        const int nig = WGM * nN, gid = wgid / nig, fm = gid * WGM, gsz = (nM - fm) < WGM ? (nM - fm) : WGM;
        u.pm = fm + ((wgid % nig) % gsz); u.pn = (wgid % nig) / gsz; return true;
    }
    __device__ __forceinline__ void a_ready(const Unit&) const {}
    __device__ __forceinline__ void done(const Unit&) const {}
};

typedef float cvt_f32x2_t __attribute__((ext_vector_type(2))); typedef __bf16 cvt_bf16x2_t __attribute__((ext_vector_type(2)));
__device__ __forceinline__ unsigned cvt_pk_bf16(float lo, float hi) { cvt_f32x2_t v = {lo, hi}; cvt_bf16x2_t b = __builtin_convertvector(v, cvt_bf16x2_t); return __builtin_bit_cast(unsigned, b); }
typedef float f32x2 __attribute__((ext_vector_type(2)));
__device__ __forceinline__ f32x2 gelu_pk(f32x2 v) {
    const f32x2 av = __builtin_elementwise_abs(v), d = av * 0.2316418882f + 1.0f;
    f32x2 t; t.x = __builtin_amdgcn_rcpf(d.x); t.y = __builtin_amdgcn_rcpf(d.y);
    f32x2 q = t * 0.5307027145f + (-0.7265760135f); q = q * t + 0.7107068705f; q = q * t + (-0.142248368f); q = q * t + 0.127414796f; q = q * t;
    const f32x2 s = (v * v) * (-0.72134752044f);
    f32x2 e; e.x = __builtin_amdgcn_exp2f(s.x); e.y = __builtin_amdgcn_exp2f(s.y);
    const f32x2 m = v * (q * e), r = v - m;
    f32x2 o; o.x = v.x < 0.f ? m.x : r.x; o.y = v.y < 0.f ? m.y : r.y; return o;
}

template <int ACT  > struct EpiBf16 {
    static constexpr bool PERM = true, AFTER_DRAIN = false; static_assert(ACT == 0 || ACT == 1, "EpiBf16: ACT is 0 (none) or 1 (gelu_pk)");
    bf16_t* O; int ldc; const float* bias; int split_cols; size_t split_stride; float scale0;
    __device__ __forceinline__ void operator()(const f32x4 (&acc)[2][2][4][2], const Unit& u, int wr, int wc, int fr, int fq) const {
        const int row0 = u.pm * BM + wr * 64 + fr; int colt = u.pn * BM; bf16_t* base = O;
        float sc = 1.f; if (split_cols) { const int t = colt / split_cols; base += (size_t)t * split_stride; colt -= t * split_cols; if (t == 0) sc = scale0; }
        const int col0 = colt + wc * 32 + 8 * fq, bcol0 = u.pn * BM + wc * 32 + 8 * fq;
        f32x4 bv[2][2];
#pragma unroll
        for (int bj = 0; bj < 2; ++bj)
#pragma unroll
            for (int n = 0; n < 2; ++n) bv[bj][n] = bias ? *(const f32x4*)(bias + bcol0 + bj * HALF + 4 * n) : (f32x4){0.f, 0.f, 0.f, 0.f};
#pragma unroll
        for (int ai = 0; ai < 2; ++ai)
#pragma unroll
            for (int m = 0; m < 4; ++m) { bf16_t* rowp = base + (size_t)(row0 + ai * HALF + m * 16) * ldc + col0;
#pragma unroll
                for (int bj = 0; bj < 2; ++bj) { f32x4 v0 = acc[ai][bj][m][0] + bv[bj][0], v1 = acc[ai][bj][m][1] + bv[bj][1];
                    if (ACT == 1) { f32x2 a = gelu_pk((f32x2){v0[0], v0[1]}), b = gelu_pk((f32x2){v0[2], v0[3]}), c = gelu_pk((f32x2){v1[0], v1[1]}), d = gelu_pk((f32x2){v1[2], v1[3]});
                        v0 = (f32x4){a.x, a.y, b.x, b.y}; v1 = (f32x4){c.x, c.y, d.x, d.y}; }
                    v0 = v0 * sc; v1 = v1 * sc; u32x4 w; w.x = cvt_pk_bf16(v0[0], v0[1]); w.y = cvt_pk_bf16(v0[2], v0[3]); w.z = cvt_pk_bf16(v1[0], v1[1]); w.w = cvt_pk_bf16(v1[2], v1[3]);
                    *(u32x4*)(rowp + bj * HALF) = w; } }
    }
};
constexpr int SSTR = 8192 + 32;
__device__ __forceinline__ void row_stats_table(const float* S, int pm, int wr, int lane, PG8_LAS float* tab) {
    const int half = lane >> 5, rl = (lane & 31) * 2;
    const f32x4* sp = (const f32x4*)((const f32x2*)S + (size_t)(pm * BM + half * HALF + wr * 64 + rl));
    float s0 = 0.f, q0 = 0.f, s1 = 0.f, q1 = 0.f;
#pragma unroll
    for (int b = 0; b < 4; ++b) { f32x4 v[8];
#pragma unroll
        for (int i = 0; i < 8; ++i) v[i] = sp[(size_t)(b * 8 + i) * (SSTR / 2)];
        asm volatile("" : "+v"(v[0]), "+v"(v[1]), "+v"(v[2]), "+v"(v[3]), "+v"(v[4]), "+v"(v[5]), "+v"(v[6]), "+v"(v[7]));
#pragma unroll
        for (int i = 0; i < 8; ++i) { s0 += v[i][0]; q0 += v[i][1]; s1 += v[i][2]; q1 += v[i][3]; } }
    const float m0 = s0 * (1.0f / 2048.0f), m1 = s1 * (1.0f / 2048.0f);
    f32x4 t; t[0] = m0; t[1] = 1.0f / sqrtf(q0 * (1.0f / 2048.0f) - m0 * m0 + 1e-5f); t[2] = m1; t[3] = 1.0f / sqrtf(q1 * (1.0f / 2048.0f) - m1 * m1 + 1e-5f);
    *(PG8_LAS f32x4*)(tab + (half * 64 + rl) * 2) = t;
    asm volatile("s_waitcnt lgkmcnt(0)" ::: "memory");
}
struct EpiBf16Ln {
    static constexpr bool PERM = true, AFTER_DRAIN = false;
    bf16_t* O; int ldc; const float* S; const float* cvec; const float* dvec; PG8_LAS unsigned char* ltab; int ln;
    __device__ __forceinline__ void operator()(const f32x4 (&acc)[2][2][4][2], const Unit& u, int wr, int wc, int fr, int fq) const {
        const int row0 = u.pm * BM + wr * 64 + fr, col0 = u.pn * BM + wc * 32 + 8 * fq;
        PG8_LAS float* tab = (PG8_LAS float*)(ltab + (wr * 4 + wc) * 1024);
        f32x4 cv[2][2], dv[2][2];
        if (ln) { PG8_LAS int* tag = (PG8_LAS int*)(ltab + 14336) + (wr * 4 + wc);
            if (__builtin_amdgcn_readfirstlane(*tag) != u.pm) { row_stats_table(S, u.pm, wr, fq * 16 + fr, tab); *tag = u.pm; }
#pragma unroll
            for (int bj = 0; bj < 2; ++bj)
#pragma unroll
                for (int n = 0; n < 2; ++n) { cv[bj][n] = *(const f32x4*)(cvec + col0 + bj * HALF + 4 * n); dv[bj][n] = *(const f32x4*)(dvec + col0 + bj * HALF + 4 * n); } }
#pragma unroll
        for (int ai = 0; ai < 2; ++ai)
#pragma unroll
            for (int m = 0; m < 4; ++m) { bf16_t* rowp = O + (size_t)(row0 + ai * HALF + m * 16) * ldc + col0;
                float rs = 1.f, t = 0.f; if (ln) { const float mu = tab[(ai * 64 + m * 16 + fr) * 2]; rs = tab[(ai * 64 + m * 16 + fr) * 2 + 1]; t = -rs * mu; }
#pragma unroll
                for (int bj = 0; bj < 2; ++bj) { f32x4 v0 = acc[ai][bj][m][0], v1 = acc[ai][bj][m][1];
                    if (ln) { v0 = v0 * rs + (cv[bj][0] * t + dv[bj][0]); v1 = v1 * rs + (cv[bj][1] * t + dv[bj][1]); }
                    u32x4 w; w.x = cvt_pk_bf16(v0[0], v0[1]); w.y = cvt_pk_bf16(v0[2], v0[3]); w.z = cvt_pk_bf16(v1[0], v1[1]); w.w = cvt_pk_bf16(v1[2], v1[3]);
                    *(u32x4*)(rowp + bj * HALF) = w; } }
    }
};
struct EpiResLn {
    static constexpr bool PERM = false, AFTER_DRAIN = false;
    const float* base; float* Y; bf16_t* YB; int ldc; float alpha; const float* Sin; const float* g; const float* b; const float* gn; float* So; PG8_LAS unsigned char* ltab; int ln;
    __device__ __forceinline__ void operator()(const f32x4 (&acc)[2][2][4][2], const Unit& u, int wr, int wc, int fr, int fq) const {
        const int row0 = u.pm * BM + wr * 64 + fr, col0 = u.pn * BM + wc * 32 + 4 * fq;
        PG8_LAS float* tab = (PG8_LAS float*)(ltab + (wr * 4 + wc) * 1024);
        PG8_LAS float* cvl = (PG8_LAS float*)(ltab + 8192 + (wr * 4 + wc) * 768);
        { const int lane = fq * 16 + fr, gc = u.pn * BM + (lane >> 5) * HALF + wc * 32 + (lane & 31); cvl[lane] = g[gc]; cvl[64 + lane] = b[gc]; cvl[128 + lane] = gn[gc]; }
        if (ln) row_stats_table(Sin, u.pm, wr, fq * 16 + fr, tab);
        f32x4 xb[3][2][2];
#pragma unroll
        for (int pr = 0; pr < 2; ++pr)
#pragma unroll
            for (int bj = 0; bj < 2; ++bj)
#pragma unroll
                for (int n = 0; n < 2; ++n) xb[pr][bj][n] = *(const f32x4*)(base + (size_t)(row0 + pr * 16) * ldc + col0 + bj * HALF + n * 16);
#pragma unroll
        for (int ai = 0; ai < 2; ++ai)
#pragma unroll
            for (int m = 0; m < 4; ++m) { const int ri = ai * 4 + m, row = row0 + ai * HALF + m * 16; const size_t off = (size_t)row * ldc + col0;
                if (ri < 6) { const int nrow = row0 + ((ri + 2) >> 2) * HALF + ((ri + 2) & 3) * 16;
#pragma unroll
                    for (int bj = 0; bj < 2; ++bj)
#pragma unroll
                        for (int n = 0; n < 2; ++n) xb[(ri + 2) % 3][bj][n] = *(const f32x4*)(base + (size_t)nrow * ldc + col0 + bj * HALF + n * 16); }
                float mu = 0.f, rs = 1.f; if (ln) { mu = tab[(ai * 64 + m * 16 + fr) * 2]; rs = tab[(ai * 64 + m * 16 + fr) * 2 + 1]; }
                float s = 0.f, q = 0.f;
#pragma unroll
                for (int bj = 0; bj < 2; ++bj)
#pragma unroll
                    for (int n = 0; n < 2; ++n) { f32x4 x = xb[ri % 3][bj][n]; const int ci = bj * 32 + n * 16 + 4 * fq;
                        if (ln) x = (x - mu) * rs * *(const PG8_LAS f32x4*)(cvl + ci) + *(const PG8_LAS f32x4*)(cvl + 64 + ci);
                        const f32x4 o = x * alpha + acc[ai][bj][m][n];
                        *(f32x4*)(Y + off + bj * HALF + n * 16) = o;
                        const f32x4 og = o * *(const PG8_LAS f32x4*)(cvl + 128 + ci);
                        unsigned w0 = cvt_pk_bf16(og[0], og[1]), w1 = cvt_pk_bf16(og[2], og[3]);
                        *(unsigned long long*)(YB + off + bj * HALF + n * 16) = ((unsigned long long)w1 << 32) | w0;
                        s += (o[0] + o[1]) + (o[2] + o[3]); q += (o[0] * o[0] + o[1] * o[1]) + (o[2] * o[2] + o[3] * o[3]); }
                s += __shfl_xor(s, 16); s += __shfl_xor(s, 32); q += __shfl_xor(q, 16); q += __shfl_xor(q, 32);
                if (fq == 0) { f32x2 sq; sq[0] = s; sq[1] = q; ((f32x2*)So)[(size_t)(u.pn * 4 + wc) * SSTR + row] = sq; } }
    }
};
template <class Epi, class Sched, bool ALIGN_EPI = false, bool SP2 = false>
__device__ __forceinline__ void gemm_phase(PG8_LAS unsigned char* lds, const Gemm g, const Sched& S, const Epi& E, const int tid_in) {
    const int tid = tid_in, wid = __builtin_amdgcn_readfirstlane(tid >> 6), lane = tid & 63, wr = wid >> 2, wc = wid & 3, fr = lane & 15, fq = lane >> 4;
    const int K = g.K, nt = K / BK;
    unsigned voffA[2], voffB[2];
#pragma unroll
    for (int i = 0; i < 2; ++i) { int R, C; stage_rc(tid * 16 + i * 8192, R, C); const int Rb = Epi::PERM ? ((R & ~31) + perm32(R & 31)) : R;
        voffA[i] = (unsigned)(R * K + C) * 2u; voffB[i] = (unsigned)(Rb * K + C) * 2u; }
    const size_t kstep = (size_t)(BK * 2);
    const size_t hstep = (size_t)HALF * K * 2;
    const size_t tstep = 2 * hstep;
    const unsigned ldsw = (unsigned)wid * 1024u;
    const int aoff = lds_byte(wr * 64 + fr, fq * 8), boff = lds_byte(wc * 32 + fr, fq * 8);
#define PG8_SA(b, h) (((b) * 2 + (h)) * HTB)
#define PG8_SB(b, h) ((4 + (b) * 2 + (h)) * HTB)
#define PG8_STAGE(bufoff, gbase, voff) do { _Pragma("unroll") for (int _i = 0; _i < 2; ++_i) \
        __builtin_amdgcn_global_load_lds((const unsigned*)((const char*)(gbase) + (voff)[_i]), (PG8_LAS unsigned*)(lds + (bufoff) + ldsw + _i * 8192), 16, 0, 0); } while (0)
#define PG8_LDA(dst, b, h) do { _Pragma("unroll") for (int m = 0; m < 4; ++m) _Pragma("unroll") for (int k = 0; k < 2; ++k) dst[m][k] = *(const PG8_LAS bf16x8*)(lds + PG8_SA(b, h) + aoff + m * 2048 + k * 1024); } while (0)
#define PG8_LDB(dst, b, h) do { _Pragma("unroll") for (int n = 0; n < 2; ++n) _Pragma("unroll") for (int k = 0; k < 2; ++k) dst[n][k] = *(const PG8_LAS bf16x8*)(lds + PG8_SB(b, h) + boff + n * 2048 + k * 1024); } while (0)
#define PG8_MMA(ai, bj, At, Bt) do { __builtin_amdgcn_s_setprio(1); _Pragma("unroll") for (int m = 0; m < 4; ++m) _Pragma("unroll") for (int n = 0; n < 2; ++n) _Pragma("unroll") for (int k = 0; k < 2; ++k) \
        acc[ai][bj][m][n] = __builtin_amdgcn_mfma_f32_16x16x32_bf16(Bt[n][k], At[m][k], acc[ai][bj][m][n], 0, 0, 0); __builtin_amdgcn_s_setprio(0); } while (0)
#define PG8_WAIT_V(n) asm volatile("s_waitcnt vmcnt(" #n ")" ::: "memory")
#define PG8_WAIT_L(n) asm volatile("s_waitcnt lgkmcnt(" #n ")" ::: "memory")
#define PG8_BAR __builtin_amdgcn_s_barrier()
#define PG8_SCHED __builtin_amdgcn_sched_barrier(0)
    Unit cur, nxt; int ui = 0;
    if (!S.next(0, cur)) return;
    f32x4 acc[2][2][4][2];
#pragma unroll
    for (int a = 0; a < 2; ++a)
#pragma unroll
        for (int b = 0; b < 2; ++b)
#pragma unroll
            for (int m = 0; m < 4; ++m)
#pragma unroll
                for (int n = 0; n < 2; ++n) acc[a][b][m][n] = (f32x4){0.f, 0.f, 0.f, 0.f};
    bf16x8 At[4][2], B0[2][2], B1[2][2];
    const char* cA = (const char*)g.A + (size_t)cur.pm * tstep; const char* cB = (const char*)g.Bt + (size_t)cur.pn * tstep;
    S.a_ready(cur);
    if constexpr (SP2) {
        PG8_STAGE(PG8_SB(0, 0), cB, voffB); PG8_STAGE(PG8_SB(0, 1), cB + hstep, voffB); PG8_STAGE(PG8_SA(0, 0), cA, voffA); PG8_STAGE(PG8_SA(0, 1), cA + hstep, voffA);
        if (wr == 1) PG8_BAR;
        PG8_WAIT_V(2); PG8_BAR;
        PG8_STAGE(PG8_SB(1, 0), cB + kstep, voffB); PG8_STAGE(PG8_SA(1, 0), cA + kstep, voffA); PG8_STAGE(PG8_SB(1, 1), cB + hstep + kstep, voffB);
        PG8_WAIT_V(6); PG8_BAR;
    } else {
        PG8_STAGE(PG8_SB(0, 0), cB, voffB); PG8_STAGE(PG8_SA(0, 0), cA, voffA); PG8_STAGE(PG8_SB(0, 1), cB + hstep, voffB); PG8_STAGE(PG8_SA(0, 1), cA + hstep, voffA);
        if (wr == 1) PG8_BAR;
        PG8_WAIT_V(4); PG8_BAR;
        PG8_STAGE(PG8_SB(1, 0), cB + kstep, voffB); PG8_STAGE(PG8_SA(1, 0), cA + kstep, voffA); PG8_STAGE(PG8_SB(1, 1), cB + hstep + kstep, voffB);
        PG8_WAIT_V(6); PG8_BAR;
    }
    for (;;) {
        const bool has_next = S.next(ui + 1, nxt);
        const char* nA = has_next ? (const char*)g.A + (size_t)nxt.pm * tstep : cA; const char* nB = has_next ? (const char*)g.Bt + (size_t)nxt.pn * tstep : cB;
        for (int t = 0; t < nt; t += 2) {
            const bool last = (t == nt - 2);
            const char* a1 = cA + (size_t)(t + 1) * kstep;
            const char* a2 = last ? nA : cA + (size_t)(t + 2) * kstep; const char* b2 = last ? nB : cB + (size_t)(t + 2) * kstep;
            const char* a3 = a2 + kstep; const char* b3 = b2 + kstep;
            if (last && has_next) S.a_ready(nxt);
            if constexpr (SP2) {
            PG8_LDB(B0, 0, 0); PG8_LDB(B1, 0, 1); PG8_SCHED; PG8_LDA(At, 0, 0); PG8_STAGE(PG8_SA(1, 1), a1 + hstep, voffA);
            PG8_WAIT_V(8); PG8_WAIT_L(0); PG8_BAR; PG8_MMA(0, 0, At, B0); PG8_MMA(0, 1, At, B1); PG8_BAR; PG8_SCHED;
            PG8_LDA(At, 0, 1); PG8_STAGE(PG8_SB(0, 0), b2, voffB); PG8_STAGE(PG8_SB(0, 1), b2 + hstep, voffB); PG8_STAGE(PG8_SA(0, 0), a2, voffA);
            PG8_WAIT_V(8); PG8_WAIT_L(0); PG8_BAR; PG8_MMA(1, 0, At, B0); PG8_MMA(1, 1, At, B1); PG8_BAR; PG8_SCHED;
            PG8_LDB(B0, 1, 0); PG8_LDB(B1, 1, 1); PG8_SCHED; PG8_LDA(At, 1, 0); PG8_STAGE(PG8_SA(0, 1), a2 + hstep, voffA);
            PG8_WAIT_V(8); PG8_WAIT_L(0); PG8_BAR; PG8_MMA(0, 0, At, B0); PG8_MMA(0, 1, At, B1); PG8_BAR; PG8_SCHED;
            PG8_LDA(At, 1, 1); PG8_STAGE(PG8_SB(1, 0), b3, voffB); PG8_STAGE(PG8_SB(1, 1), b3 + hstep, voffB); PG8_STAGE(PG8_SA(1, 0), a3, voffA);
            PG8_WAIT_V(8); PG8_WAIT_L(0); PG8_BAR; PG8_MMA(1, 0, At, B0); PG8_MMA(1, 1, At, B1); PG8_BAR; PG8_SCHED;
            } else {
            PG8_LDB(B0, 0, 0); PG8_SCHED; PG8_LDA(At, 0, 0); PG8_STAGE(PG8_SA(1, 1), a1 + hstep, voffA);
            PG8_WAIT_L(8); PG8_BAR; PG8_WAIT_L(0); PG8_MMA(0, 0, At, B0); PG8_BAR; PG8_SCHED;
            PG8_LDB(B1, 0, 1); PG8_STAGE(PG8_SB(0, 0), b2, voffB);
            PG8_BAR; PG8_WAIT_L(0); PG8_MMA(0, 1, At, B1); PG8_BAR;
            PG8_LDA(At, 0, 1); PG8_STAGE(PG8_SA(0, 0), a2, voffA);
            PG8_BAR; PG8_WAIT_L(0); PG8_MMA(1, 0, At, B0); PG8_BAR; PG8_SCHED;
            PG8_STAGE(PG8_SB(0, 1), b2 + hstep, voffB);
            PG8_WAIT_V(6); PG8_BAR; PG8_MMA(1, 1, At, B1); PG8_BAR;
            PG8_LDB(B0, 1, 0); PG8_SCHED; PG8_LDA(At, 1, 0); PG8_STAGE(PG8_SA(0, 1), a2 + hstep, voffA);
            PG8_WAIT_L(8); PG8_BAR; PG8_WAIT_L(0); PG8_MMA(0, 0, At, B0); PG8_BAR; PG8_SCHED;
            PG8_LDB(B1, 1, 1); PG8_STAGE(PG8_SB(1, 0), b3, voffB);
            PG8_BAR; PG8_WAIT_L(0); PG8_MMA(0, 1, At, B1); PG8_BAR;
            PG8_LDA(At, 1, 1); PG8_STAGE(PG8_SA(1, 0), a3, voffA);
            PG8_BAR; PG8_WAIT_L(0); PG8_MMA(1, 0, At, B0); PG8_BAR; PG8_SCHED;
            PG8_STAGE(PG8_SB(1, 1), b3 + hstep, voffB);
            PG8_WAIT_V(6); PG8_BAR; PG8_MMA(1, 1, At, B1); PG8_BAR;
            }
        }
        if constexpr (ALIGN_EPI) { if (wr == 0) PG8_BAR; }
        if constexpr (!Epi::AFTER_DRAIN) { E(acc, cur, wr, wc, fr, fq); S.done(cur); }
        if (!has_next) break;
#pragma unroll
        for (int a = 0; a < 2; ++a)
#pragma unroll
            for (int b = 0; b < 2; ++b)
#pragma unroll
                for (int m = 0; m < 4; ++m)
#pragma unroll
                    for (int n = 0; n < 2; ++n) acc[a][b][m][n] = (f32x4){0.f, 0.f, 0.f, 0.f};
        cur = nxt; cA = nA; cB = nB; ++ui;
        if constexpr (ALIGN_EPI) { if (wr == 1) PG8_BAR; }
    }
    PG8_WAIT_V(0);
    if constexpr (!ALIGN_EPI) { if (wr == 0) PG8_BAR; }
    PG8_BAR;
    if constexpr (Epi::AFTER_DRAIN) { E.fused(acc, cur, wr, wc, fr, fq, lds, wid, lane); S.done(cur); }
#undef PG8_SA
#undef PG8_SB
#undef PG8_STAGE
#undef PG8_LDA
#undef PG8_LDB
#undef PG8_MMA
#undef PG8_WAIT_V
#undef PG8_WAIT_L
#undef PG8_BAR
#undef PG8_SCHED
}
}
namespace cg = cooperative_groups;
#define LAS __attribute__((address_space(3)))
typedef unsigned short bf16;
typedef unsigned v4u __attribute__((ext_vector_type(4)));
typedef unsigned v2u __attribute__((ext_vector_type(2)));
typedef float f32x4 __attribute__((ext_vector_type(4)));
typedef float f32x16 __attribute__((ext_vector_type(16)));
typedef short bf16x8 __attribute__((ext_vector_type(8)));
typedef short s16x4 __attribute__((ext_vector_type(4)));

constexpr int T = 8192, SEQ = 2048, D = 2048, INW = 5120, FF = 5632, FF2 = 11264, DEPTH = 4;
constexpr int NPHASE = 2 + 6 * DEPTH;
constexpr float LOG2E = 1.4426950408889634f;
constexpr float DN_ALPHA = 1.681792830507429f;
constexpr size_t MiB = 1u << 20;
constexpr size_t WS_CTL = 0, CTL_BYTES = 1 * MiB, WS_SUM = 1 * MiB, WS_GT = 2 * MiB, WS_WIN = 4 * MiB, WS_WOUT = 84 * MiB, WS_WUP = 116 * MiB, WS_WDN = 292 * MiB,
                 WS_S1 = 404 * MiB, WS_S2 = 408 * MiB, WS_CD = 384 * MiB, WS_PCD = 386 * MiB, WS_Y = 508 * MiB, WS_XBF = 572 * MiB, WS_PROJ = 604 * MiB, WS_MIX = 684 * MiB, WS_Z = 716 * MiB, WS_H = 892 * MiB, WS_END = 980 * MiB;
constexpr int LDS_BYTES = 147456;

__device__ __forceinline__ unsigned cvtpk(float lo, float hi) { return pg8::cvt_pk_bf16(lo, hi); }
__device__ __forceinline__ float bf2f(bf16 v) { return __uint_as_float((unsigned)v << 16); }
__device__ __forceinline__ float bflo(unsigned w) { return __uint_as_float(w << 16); }
__device__ __forceinline__ float bfhi(unsigned w) { return __uint_as_float(w & 0xffff0000u); }
__device__ __forceinline__ float ex2(float x) { return __builtin_amdgcn_exp2f(x); }
__device__ __forceinline__ float rcp(float x) { return __builtin_amdgcn_rcpf(x); }
__device__ __forceinline__ float sigmoidf_(float x) { return rcp(1.0f + ex2(-LOG2E * x)); }
__device__ __forceinline__ float gelu_tanh(float x) { const float y = x * (1.0f + 0.044715f * x * x); return x * rcp(1.0f + ex2(-2.0f * 0.7978845608028654f * LOG2E * y)); }
__device__ __forceinline__ float wave_sum(float v) {
#pragma unroll
    for (int o = 1; o < 64; o <<= 1) v += __shfl_xor(v, o);
    return v;
}

__device__ __forceinline__ void transpose_item(const float* __restrict__ W, int K, int N, bf16* __restrict__ WT, LAS float* scr, int item, int lane) {
    const int nblk = N / 32, kb = item / nblk, nb = item % nblk, k0 = 64 * kb, n0 = 32 * nb;
    const float* Wb = W + (size_t)k0 * N + n0; const unsigned loff = (unsigned)(lane >> 5) * (unsigned)N + (unsigned)(lane & 31);
#pragma unroll 8
    for (int i = 0; i < 32; ++i) { const int kk = 2 * i + (lane >> 5); scr[kk * 33 + (lane & 31)] = (Wb + (size_t)(2 * i) * N)[loff]; }
    asm volatile("s_waitcnt lgkmcnt(0)" ::: "memory");
    const int c = lane & 7;
#pragma unroll
    for (int j = 0; j < 4; ++j) { const int n = (lane >> 3) + 8 * j; const LAS float* s = scr + (8 * c) * 33 + n;
        v4u o; o.x = cvtpk(s[0 * 33], s[1 * 33]); o.y = cvtpk(s[2 * 33], s[3 * 33]); o.z = cvtpk(s[4 * 33], s[5 * 33]); o.w = cvtpk(s[6 * 33], s[7 * 33]);
        *(v4u*)(WT + (size_t)(n0 + n) * K + k0 + 8 * c) = o; }
    asm volatile("s_waitcnt lgkmcnt(0)" ::: "memory");
}

__device__ __forceinline__ void fold_rows(const bf16* __restrict__ Wt, const float* __restrict__ g, const float* __restrict__ b, float* __restrict__ c, float* __restrict__ d, int r0, int r1, int lane) {
    float gr[4][8], br[4][8];
#pragma unroll
    for (int j = 0; j < 4; ++j) { const f32x4 g0 = *(const f32x4*)(g + 512 * j + 8 * lane), g1 = *(const f32x4*)(g + 512 * j + 8 * lane + 4), b0 = *(const f32x4*)(b + 512 * j + 8 * lane), b1 = *(const f32x4*)(b + 512 * j + 8 * lane + 4);
#pragma unroll
        for (int e = 0; e < 4; ++e) { gr[j][e] = g0[e]; gr[j][4 + e] = g1[e]; br[j][e] = b0[e]; br[j][4 + e] = b1[e]; } }
    for (int r = r0; r < r1; ++r) { const v4u* wp = (const v4u*)(Wt + (size_t)r * D) + lane; v4u w[4];
#pragma unroll
        for (int j = 0; j < 4; ++j) w[j] = wp[64 * j];
        float cs = 0.f, ds = 0.f;
#pragma unroll
        for (int j = 0; j < 4; ++j)
#pragma unroll
            for (int e = 0; e < 4; ++e) { const float lo = bflo(w[j][e]), hi = bfhi(w[j][e]); cs += gr[j][2 * e] * lo + gr[j][2 * e + 1] * hi; ds += br[j][2 * e] * lo + br[j][2 * e + 1] * hi; }
        cs = wave_sum(cs); ds = wave_sum(ds);
        if (lane == 0) { c[r] = cs; d[r] = ds; } }
}
struct Args { const float* in[23]; float* out; unsigned char* ws; int ph_lo, ph_hi; };

__device__ __forceinline__ void prologue(const Args& a, LAS unsigned char* lds, int G, const int tid_in) {
    const int tid = tid_in, lane = tid & 63, wave = __builtin_amdgcn_readfirstlane(tid >> 6);
    LAS float* scr = (LAS float*)(lds + wave * 16384);
    const int gw = blockIdx.x * 8 + wave, NGW = G * 8;
    unsigned char* ws = a.ws;
    constexpr int I_IN = 32 * 160, I_OUT = 32 * 64, I_UP = 32 * 352, I_DN = 88 * 64, I_L = I_IN + I_OUT + I_UP + I_DN;
    for (int it = gw; it < DEPTH * I_L; it += NGW) {
        const int l = it / I_L; int r = it % I_L;
        if (r < I_IN) { transpose_item(a.in[1] + (size_t)l * D * INW, D, INW, (bf16*)(ws + WS_WIN) + (size_t)l * INW * D, scr, r, lane); continue; } r -= I_IN;
        if (r < I_OUT) { transpose_item(a.in[14] + (size_t)l * D * D, D, D, (bf16*)(ws + WS_WOUT) + (size_t)l * D * D, scr, r, lane); continue; } r -= I_OUT;
        if (r < I_UP) { transpose_item(a.in[17] + (size_t)l * D * FF2, D, FF2, (bf16*)(ws + WS_WUP) + (size_t)l * FF2 * D, scr, r, lane); continue; } r -= I_UP;
        transpose_item(a.in[20] + (size_t)l * FF * D, FF, D, (bf16*)(ws + WS_WDN) + (size_t)l * D * FF, scr, r, lane);
    }
    const int gt = blockIdx.x * 512 + tid, NT_ = G * 512;
    { bf16* Gt = (bf16*)(ws + WS_GT);
      for (int idx = gt; idx < DEPTH * 16 * 2 * 64 * 64; idx += NT_) { const int i = idx & 63, j = (idx >> 6) & 63, mat = (idx >> 12) & 1, lg = idx >> 13;
          const float v = (mat ? a.in[6] : a.in[4])[((size_t)lg * 64 + i) * 64 + j]; Gt[idx] = (bf16)(cvtpk(v, 0.f) & 0xffffu); } }
    { const f32x4* xs = (const f32x4*)a.in[0]; v2u* xo = (v2u*)(ws + WS_XBF);
      for (int idx = gt; idx < T * D / 4; idx += NT_) { const f32x4 v = xs[idx]; v2u o; o.x = cvtpk(v.x, v.y); o.y = cvtpk(v.z, v.w); xo[idx] = o; } }
}

__device__ __forceinline__ void fold_phase(const Args& a, int G, const int tid_in) {
    const int lane = tid_in & 63, wave = __builtin_amdgcn_readfirstlane(tid_in >> 6);
    const int gw = blockIdx.x * 8 + wave, NGW = G * 8;
    constexpr int NROWS = 3 * INW + 4 * FF2;
    const int per = (NROWS + NGW - 1) / NGW; int r = gw * per; const int rend = (r + per < NROWS) ? r + per : NROWS;
    float* cd = (float*)(a.ws + WS_CD);
    while (r < rend) {
        int l, base, nrow, isup;
        if (r < 3 * INW) { l = 1 + r / INW; base = (l - 1) * INW; nrow = INW; isup = 0; } else { l = (r - 3 * INW) / FF2; base = 3 * INW + l * FF2; nrow = FF2; isup = 1; }
        const int e = (base + nrow < rend) ? base + nrow : rend;
        const bf16* Wt = isup ? (const bf16*)(a.ws + WS_WUP) + (size_t)l * FF2 * D : (const bf16*)(a.ws + WS_WIN) + (size_t)l * INW * D;
        const float* g = isup ? a.in[15] + (size_t)l * D : a.in[21] + (size_t)(l - 1) * D; const float* b = isup ? a.in[16] + (size_t)l * D : a.in[22] + (size_t)(l - 1) * D;
        float* c = cd + (size_t)l * 32768 + (isup ? 10240 : 0); float* d = cd + (size_t)l * 32768 + (isup ? 21504 : 5120);
        fold_rows(Wt, g, b, c, d, r - base, e - base, lane);
        r = e;
    }
}

__device__ __forceinline__ void ln_phase(const float* __restrict__ Y, const float* __restrict__ g, const float* __restrict__ b, float* __restrict__ outF, int G, const int tid_in) {
    const int tid = tid_in, lane = tid & 63, wave = tid >> 6;
    const int gw = blockIdx.x * 8 + wave, NGW = G * 8;
    for (int m = gw; m < T; m += NGW) {
        const f32x4* yr = (const f32x4*)(Y + (size_t)m * D) + lane;
        f32x4 v[8]; float s = 0.f;
#pragma unroll
        for (int j = 0; j < 8; ++j) { v[j] = yr[64 * j]; s += (v[j].x + v[j].y) + (v[j].z + v[j].w); }
        const float mean = wave_sum(s) * (1.f / D); float s2 = 0.f;
#pragma unroll
        for (int j = 0; j < 8; ++j) { v[j] = v[j] - mean; s2 += (v[j].x * v[j].x + v[j].y * v[j].y) + (v[j].z * v[j].z + v[j].w * v[j].w); }
        const float rstd = 1.f / sqrtf(wave_sum(s2) * (1.f / D) + 1e-5f);
        f32x4* of = (f32x4*)(outF + (size_t)m * D) + lane;
#pragma unroll
        for (int j = 0; j < 8; ++j) { const f32x4 gg = ((const f32x4*)g)[lane + 64 * j], bb = ((const f32x4*)b)[lane + 64 * j];
            const f32x4 o = v[j] * rstd * gg + bb; of[64 * j] = o; }
    }
}

__device__ __forceinline__ void convgelu_phase(const bf16* __restrict__ Z, const float* __restrict__ cw, const float* __restrict__ cb, bf16* __restrict__ H, int G, const int tid_in) {
    const int gid = blockIdx.x * 512 + tid_in, NTH = G * 512;
    constexpr int CG_ROWS = 16;
    for (int it = gid; it < (T / CG_ROWS) * (FF / 8); it += NTH) {
        const int fc = it % (FF / 8), rb = it / (FF / 8), f = fc * 8, t0 = rb * CG_ROWS;
        float wg[3][8], wu[3][8], bg[8], bu[8];
#pragma unroll
        for (int k = 0; k < 3; ++k) { const f32x4 a0 = *(const f32x4*)(cw + k * FF2 + f), a1 = *(const f32x4*)(cw + k * FF2 + f + 4), c0 = *(const f32x4*)(cw + k * FF2 + FF + f), c1 = *(const f32x4*)(cw + k * FF2 + FF + f + 4);
#pragma unroll
            for (int e = 0; e < 4; ++e) { wg[k][e] = a0[e]; wg[k][4 + e] = a1[e]; wu[k][e] = c0[e]; wu[k][4 + e] = c1[e]; } }
        { const f32x4 a0 = *(const f32x4*)(cb + f), a1 = *(const f32x4*)(cb + f + 4), c0 = *(const f32x4*)(cb + FF + f), c1 = *(const f32x4*)(cb + FF + f + 4);
#pragma unroll
          for (int e = 0; e < 4; ++e) { bg[e] = a0[e]; bg[4 + e] = a1[e]; bu[e] = c0[e]; bu[4 + e] = c1[e]; } }
        v4u g2 = {0, 0, 0, 0}, g1 = {0, 0, 0, 0}, u2 = {0, 0, 0, 0}, u1 = {0, 0, 0, 0};
        const bf16* zp = Z + (size_t)t0 * FF2 + f;
        if ((t0 & (SEQ - 1)) != 0) { g2 = *(const v4u*)(zp - 2 * (size_t)FF2); g1 = *(const v4u*)(zp - (size_t)FF2); u2 = *(const v4u*)(zp - 2 * (size_t)FF2 + FF); u1 = *(const v4u*)(zp - (size_t)FF2 + FF); }
        bf16* hp = H + (size_t)t0 * FF + f;
        for (int n4 = 0; n4 < CG_ROWS; n4 += 4) {
            v4u gq[4], uq[4];
#pragma unroll
            for (int i = 0; i < 4; ++i) { gq[i] = *(const v4u*)(zp + (size_t)(n4 + i) * FF2); uq[i] = *(const v4u*)(zp + (size_t)(n4 + i) * FF2 + FF); }
#pragma unroll
            for (int i = 0; i < 4; ++i) { const v4u g0 = gq[i], u0 = uq[i];
                float o[8];
#pragma unroll
                for (int e = 0; e < 4; ++e) {
                    const float ga = bg[2 * e] + wg[0][2 * e] * bflo(g2[e]) + wg[1][2 * e] * bflo(g1[e]) + wg[2][2 * e] * bflo(g0[e]);
                    const float gb = bg[2 * e + 1] + wg[0][2 * e + 1] * bfhi(g2[e]) + wg[1][2 * e + 1] * bfhi(g1[e]) + wg[2][2 * e + 1] * bfhi(g0[e]);
                    const float ua = bu[2 * e] + wu[0][2 * e] * bflo(u2[e]) + wu[1][2 * e] * bflo(u1[e]) + wu[2][2 * e] * bflo(u0[e]);
                    const float ub = bu[2 * e + 1] + wu[0][2 * e + 1] * bfhi(u2[e]) + wu[1][2 * e + 1] * bfhi(u1[e]) + wu[2][2 * e + 1] * bfhi(u0[e]);
                    o[2 * e] = gelu_tanh(ga) * ua; o[2 * e + 1] = gelu_tanh(gb) * ub;
                }
                v4u w; w.x = cvtpk(o[0], o[1]); w.y = cvtpk(o[2], o[3]); w.z = cvtpk(o[4], o[5]); w.w = cvtpk(o[6], o[7]);
                *(v4u*)(hp + (size_t)(n4 + i) * FF) = w;
                g2 = g1; g1 = g0; u2 = u1; u1 = u0; }
        }
    }
}

__device__ __forceinline__ void rg_item(LAS unsigned char* lds, int item, const bf16* __restrict__ proj, bf16* __restrict__ mix, const bf16* __restrict__ Gt,
                                        const float* __restrict__ conv_w, const float* __restrict__ conv_b, const float* __restrict__ ba, const float* __restrict__ bx,
                                        const float* __restrict__ lamp, unsigned* masks, unsigned long long* slots, const int tid_in) {
    const int tid = tid_in, lane = tid & 63, wid = __builtin_amdgcn_readfirstlane(tid >> 6);
    const int kblk = item >> 6, bg = item & 63, b = bg >> 4, g = bg & 15, t0 = kblk * 256;
    const size_t rowbase = (size_t)b * SEQ;
    LAS float* U = (LAS float*)lds;
    LAS unsigned char* RAW = lds + 69632;
    { const bf16* xg = proj + rowbase * INW + 64 * g; v4u rawv[5];
#pragma unroll
      for (int i5 = 0; i5 < 5; ++i5) { const int c = tid + 512 * i5, r = c >> 3, t = t0 - 3 + r; rawv[i5] = (v4u){0u, 0u, 0u, 0u};
          if (c < 259 * 8 && t >= 0) rawv[i5] = *(const v4u*)(xg + (size_t)t * INW + (c & 7) * 8); }
#pragma unroll
      for (int i5 = 0; i5 < 5; ++i5) { const int c = tid + 512 * i5; if (c < 259 * 8) *(LAS v4u*)(RAW + c * 16) = rawv[i5]; } }
    __syncthreads();
    { const int i = tid & 63, run = tid >> 6, ch = 64 * g + i;
      const float w0 = conv_w[ch], w1 = conv_w[1024 + ch], w2 = conv_w[2048 + ch], w3 = conv_w[3072 + ch], cbv = conv_b[ch];
      const LAS bf16* xr = (const LAS bf16*)RAW + (run * 32) * 64 + i;
      float x0 = bf2f(xr[0]), x1 = bf2f(xr[64]), x2 = bf2f(xr[128]);
#pragma unroll 8
      for (int n = 0; n < 32; ++n) { const float x3 = bf2f(xr[(n + 3) * 64]); U[(run * 32 + n) * 68 + i] = cbv + w0 * x0 + w1 * x1 + w2 * x2 + w3 * x3; x0 = x1; x1 = x2; x2 = x3; } }
    __syncthreads();
    const int cb = wid & 3, th = wid >> 2, seg = kblk * 2 + th;
    const int q = lane >> 4, c16 = lane & 15, j = 16 * cb + c16, ch = 64 * g + j;
    const bf16* gp = Gt + ((size_t)(g * 2) * 64 + j) * 64 + 8 * q;
    bf16x8 Ba[2], Bx[2];
#pragma unroll
    for (int s = 0; s < 2; ++s) { Ba[s] = *(const bf16x8*)(gp + 32 * s); Bx[s] = *(const bf16x8*)(gp + 4096 + 32 * s); }
    const float bav = ba[ch], bxv = bx[ch];
    const float c2 = -8.0f * log1pf(__expf(-lamp[ch])) * LOG2E;
    const bf16* gbase = proj + (rowbase + t0 + th * 128) * INW + 1024 + 64 * g;
    const unsigned goff = (unsigned)(4 * q) * INW + j;
    bf16 gtv[8][4];
#pragma unroll
    for (int mt = 0; mt < 8; ++mt)
#pragma unroll
        for (int r = 0; r < 4; ++r) gtv[mt][r] = (gbase + (size_t)(mt * 16 + r) * INW)[goff];
    asm volatile("" ::: "memory");
    float Hl[8][4], Pc[8][4]; float cP = 1.f, cH = 0.f;
#pragma unroll
    for (int mt = 0; mt < 8; ++mt) {
        const int rt = th * 128 + mt * 16;
        const LAS float* ur = U + (rt + c16) * 68 + 8 * q;
        const f32x4 a0 = *(const LAS f32x4*)(ur), a1 = *(const LAS f32x4*)(ur + 4), a2 = *(const LAS f32x4*)(ur + 32), a3 = *(const LAS f32x4*)(ur + 36);
        v4u A0u, A1u; A0u.x = cvtpk(a0.x, a0.y); A0u.y = cvtpk(a0.z, a0.w); A0u.z = cvtpk(a1.x, a1.y); A0u.w = cvtpk(a1.z, a1.w);
        A1u.x = cvtpk(a2.x, a2.y); A1u.y = cvtpk(a2.z, a2.w); A1u.z = cvtpk(a3.x, a3.y); A1u.w = cvtpk(a3.z, a3.w);
        const bf16x8 A0 = __builtin_bit_cast(bf16x8, A0u), A1 = __builtin_bit_cast(bf16x8, A1u);
        f32x4 accr = {0.f, 0.f, 0.f, 0.f}, acci = {0.f, 0.f, 0.f, 0.f};
        accr = __builtin_amdgcn_mfma_f32_16x16x32_bf16(A0, Ba[0], accr, 0, 0, 0); accr = __builtin_amdgcn_mfma_f32_16x16x32_bf16(A1, Ba[1], accr, 0, 0, 0);
        acci = __builtin_amdgcn_mfma_f32_16x16x32_bf16(A0, Bx[0], acci, 0, 0, 0); acci = __builtin_amdgcn_mfma_f32_16x16x32_bf16(A1, Bx[1], acci, 0, 0, 0);
        float av[4], bv[4];
#pragma unroll
        for (int r = 0; r < 4; ++r) {
            const float u = U[(rt + 4 * q + r) * 68 + j];
            const float rr = sigmoidf_(accr[r] + bav), ig = sigmoidf_(acci[r] + bxv);
            const float l2a = c2 * rr, a = ex2(l2a), x = 2.0f * 0.6931471805599453f * l2a;
            const float om = (x > -0.02f) ? -x * (1.0f + x * (0.5f + x * (1.0f / 6.0f))) : 1.0f - a * a;
            av[r] = a; bv[r] = sqrtf(om) * ig * u;
        }
        float A_ = av[0], H_ = bv[0]; Pc[mt][0] = A_; Hl[mt][0] = H_;
#pragma unroll
        for (int r = 1; r < 4; ++r) { H_ = av[r] * H_ + bv[r]; A_ *= av[r]; Pc[mt][r] = A_; Hl[mt][r] = H_; }
        float tA = A_, tH = H_;
        { const float pA = __shfl_up(tA, 16), pH = __shfl_up(tH, 16); if (q >= 1) { tH = tA * pH + tH; tA = tA * pA; } }
        { const float pA = __shfl_up(tA, 32), pH = __shfl_up(tH, 32); if (q >= 2) { tH = tA * pH + tH; tA = tA * pA; } }
        float eA = __shfl_up(tA, 16), eH = __shfl_up(tH, 16); if (q == 0) { eA = 1.f; eH = 0.f; }
        const float inA = cP * eA, inH = eA * cH + eH;
#pragma unroll
        for (int r = 0; r < 4; ++r) { Hl[mt][r] = Pc[mt][r] * inH + Hl[mt][r]; Pc[mt][r] = Pc[mt][r] * inA; }
        const float totA = __shfl(tA, 48 + c16), totH = __shfl(tH, 48 + c16);
        cH = totA * cH + totH; cP = cP * totA;
        asm volatile("" ::: "memory");
    }
    unsigned long long* sl = slots + ((size_t)b * 16) * 1024 + ch;
    if (q == 0) __hip_atomic_store(sl + (size_t)seg * 1024, ((unsigned long long)__float_as_uint(cH) << 32) | __float_as_uint(cP), __ATOMIC_RELAXED, __HIP_MEMORY_SCOPE_AGENT);
    asm volatile("s_waitcnt vmcnt(0)" ::: "memory");
    unsigned* mk = masks + bg * 4 + cb;
    if (lane == 0) __hip_atomic_fetch_or(mk, 1u << seg, __ATOMIC_RELAXED, __HIP_MEMORY_SCOPE_AGENT);
    const unsigned need = (1u << seg) - 1u;
    if (need) { unsigned sp = 0;
        while (((unsigned)__builtin_amdgcn_readfirstlane(__hip_atomic_load(mk, __ATOMIC_RELAXED, __HIP_MEMORY_SCOPE_AGENT)) & need) != need) { __builtin_amdgcn_s_sleep(2); if (++sp > (1u << 22)) break; }
        __builtin_amdgcn_fence(__ATOMIC_ACQUIRE, "agent"); }
    unsigned long long sw[15];
#pragma unroll
    for (int s2 = 0; s2 < 15; ++s2) { sw[s2] = 0ull; if (s2 < seg) sw[s2] = __hip_atomic_load(sl + (size_t)s2 * 1024, __ATOMIC_RELAXED, __HIP_MEMORY_SCOPE_AGENT); }
    float hin = 0.f;
#pragma unroll
    for (int s2 = 0; s2 < 15; ++s2) if (s2 < seg) hin = __uint_as_float((unsigned)(sw[s2] >> 32)) + __uint_as_float((unsigned)sw[s2]) * hin;
    bf16* obase = mix + (rowbase + t0 + th * 128) * D + 64 * g;
    const unsigned ooff = (unsigned)(4 * q) * D + j;
#pragma unroll
    for (int mt = 0; mt < 8; ++mt)
#pragma unroll
        for (int r = 0; r < 4; ++r) { const float hv = Hl[mt][r] + Pc[mt][r] * hin;
            const float o = hv * gelu_tanh(bf2f(gtv[mt][r])); (obase + (size_t)(mt * 16 + r) * D)[ooff] = (bf16)(cvtpk(o, 0.f) & 0xffffu); }
    __syncthreads();
}

__device__ __forceinline__ void attn_unit(LAS unsigned char* lds, const bf16* __restrict__ proj, bf16* __restrict__ mix, int b, int h, int qb, float lam, float sl2,
                                          const float* __restrict__ sg, float oscale, const int tid_in) {
    constexpr int KSTR = 144, VSTR = 320, KBY = 64 * KSTR, STG = 2 * KBY + 64 * VSTR;
    const int tid = tid_in, lane = tid & 63, wid = __builtin_amdgcn_readfirstlane(tid >> 6);
    const int comp = wid >> 2, rg = wid & 3, r32 = lane & 31, hi = lane >> 5;
    const int q0 = qb * 128 + rg * 32;
    const size_t rowbase = (size_t)b * SEQ;
    const bf16* qp = proj + (rowbase + q0 + r32) * INW + 2048 + h * 128 + comp * 64 + hi * 8;
    bf16x8 qf[4];
    const float c1 = 0.125f * LOG2E;
#pragma unroll
    for (int d0 = 0; d0 < 4; ++d0) { const v4u qv = *(const v4u*)(qp + d0 * 16); v4u qo;
#pragma unroll
        for (int e = 0; e < 4; ++e) qo[e] = cvtpk(bflo(qv[e]) * c1, bfhi(qv[e]) * c1);
        qf[d0] = __builtin_bit_cast(bf16x8, qo); }
    f32x16 o[4];
#pragma unroll
    for (int vb = 0; vb < 4; ++vb)
#pragma unroll
        for (int r = 0; r < 16; ++r) o[vb][r] = 0.f;
    float mref = 0.f, l = 0.f;
    const int NT = 2 * qb + 2;
    const int krow = tid >> 3, kch = tid & 7, vrow = tid >> 4, vch = tid & 15;
    const bf16* ksrc = proj + (rowbase + krow) * INW + 3072 + h * 128 + kch * 8;
    const bf16* vsrc = proj + (rowbase + vrow) * INW + 4096 + h * 128 + vch * 8;
    v4u rk1, rk2, rv0, rv1;
#define AT_LOAD(kt) do { const size_t o_ = (size_t)(kt) * 64 * INW; rk1 = *(const v4u*)(ksrc + o_); rk2 = *(const v4u*)(ksrc + o_ + 64); rv0 = *(const v4u*)(vsrc + o_); rv1 = *(const v4u*)(vsrc + o_ + (size_t)32 * INW); } while (0)
#define AT_STORE(buf) do { LAS unsigned char* s_ = lds + (buf) * STG; *(LAS v4u*)(s_ + krow * KSTR + kch * 16) = rk1; *(LAS v4u*)(s_ + KBY + krow * KSTR + kch * 16) = rk2; \
        *(LAS v4u*)(s_ + 2 * KBY + vrow * VSTR + vch * 16) = rv0; *(LAS v4u*)(s_ + 2 * KBY + (vrow + 32) * VSTR + vch * 16) = rv1; } while (0)
    AT_LOAD(0); AT_STORE(0); __syncthreads();
    const int qpos = q0 + r32;
    for (int kt = 0; kt < NT; ++kt) {
        const bool more = kt + 1 < NT;
        if (more) AT_LOAD(kt + 1);
        if (kt * 64 <= q0 + 31) {
            LAS const unsigned char* sb = lds + (kt & 1) * STG;
            LAS const unsigned char* kc = sb + comp * KBY + r32 * KSTR + hi * 16;
            f32x16 p0, p1;
            float base = sl2 * (float)(kt * 64 + 4 * hi - qpos) - mref; asm volatile("" : "+v"(base));
#pragma unroll
            for (int r = 0; r < 16; ++r) { p0[r] = __builtin_fmaf(sl2, (float)((r & 3) + 8 * (r >> 2)), base); p1[r] = __builtin_fmaf(sl2, (float)((r & 3) + 8 * (r >> 2) + 32), base); }
#pragma unroll
            for (int d0 = 0; d0 < 4; ++d0) { const bf16x8 k0 = *(LAS const bf16x8*)(kc + d0 * 32), k1 = *(LAS const bf16x8*)(kc + 32 * KSTR + d0 * 32), qv = qf[d0];
                p0 = __builtin_amdgcn_mfma_f32_32x32x16_bf16(k0, qv, p0, 0, 0, 0); p1 = __builtin_amdgcn_mfma_f32_32x32x16_bf16(k1, qv, p1, 0, 0, 0); }
            if (kt * 64 + 63 > q0) { const int dqi = qpos - kt * 64 - 4 * hi;
#pragma unroll
                for (int r = 0; r < 16; ++r) { if ((r & 3) + 8 * (r >> 2) > dqi) p0[r] = -INFINITY; if ((r & 3) + 8 * (r >> 2) + 32 > dqi) p1[r] = -INFINITY; } }
            float mx = __builtin_fmaxf(__builtin_fmaxf(p0[0], p1[0]), p0[1]);
#pragma unroll
            for (int r = 1; r < 16; ++r) mx = (r == 1) ? __builtin_fmaxf(mx, p1[1]) : __builtin_fmaxf(__builtin_fmaxf(mx, p0[r]), p1[r]);
            mx = fmaxf(mx, __shfl_xor(mx, 32));
            if (__any(mx > 8.0f)) { const float dl = fmaxf(mx, 0.f), f = ex2(-dl); mref += dl; l *= f;
#pragma unroll
                for (int r = 0; r < 16; ++r) { p0[r] -= dl; p1[r] -= dl; }
#pragma unroll
                for (int vb = 0; vb < 4; ++vb)
#pragma unroll
                    for (int r = 0; r < 16; ++r) o[vb][r] *= f; }
            float ps = 0.f;
#pragma unroll
            for (int r = 0; r < 16; ++r) { p0[r] = ex2(p0[r]); p1[r] = ex2(p1[r]); ps += p0[r] + p1[r]; }
            l += ps;
            v4u pw[4];
#pragma unroll
            for (int e = 0; e < 4; ++e) { pw[0][e] = cvtpk(p0[2 * e], p0[2 * e + 1]); pw[1][e] = cvtpk(p0[8 + 2 * e], p0[9 + 2 * e]); pw[2][e] = cvtpk(p1[2 * e], p1[2 * e + 1]); pw[3][e] = cvtpk(p1[8 + 2 * e], p1[9 + 2 * e]); }
            LAS const unsigned char* vbp = sb + 2 * KBY + (4 * hi + ((lane & 15) >> 2)) * VSTR + ((lane >> 4) & 1) * 32 + (lane & 3) * 8;
#pragma unroll
            for (int s = 0; s < 4; ++s) { const bf16x8 pf = __builtin_bit_cast(bf16x8, pw[s]);
#pragma unroll
                for (int vb = 0; vb < 4; ++vb) {
                    const s16x4 lo = __builtin_bit_cast(s16x4, __builtin_amdgcn_ds_read_tr16_b64_v4i16((LAS s16x4*)(vbp + (16 * s) * VSTR + vb * 64)));
                    const s16x4 hh = __builtin_bit_cast(s16x4, __builtin_amdgcn_ds_read_tr16_b64_v4i16((LAS s16x4*)(vbp + (16 * s + 8) * VSTR + vb * 64)));
                    const bf16x8 vf = (bf16x8){lo[0], lo[1], lo[2], lo[3], hh[0], hh[1], hh[2], hh[3]};
                    o[vb] = __builtin_amdgcn_mfma_f32_32x32x16_bf16(vf, pf, o[vb], 0, 0, 0); }
                asm volatile("" ::: "memory"); }
        }
        if (more) AT_STORE((kt + 1) & 1);
        __syncthreads();
    }
#undef AT_LOAD
#undef AT_STORE
    l += __shfl_xor(l, 32);
    const float inv = 1.0f / l;
    LAS float* X = (LAS float*)lds;
    if (comp == 1) { const float sc = inv * lam;
#pragma unroll
        for (int vb = 0; vb < 4; ++vb)
#pragma unroll
            for (int r = 0; r < 16; ++r) X[(rg * 64 + vb * 16 + r) * 64 + lane] = o[vb][r] * sc; }
    __syncthreads();
    if (comp == 0) {
        float ss = 0.f;
#pragma unroll
        for (int vb = 0; vb < 4; ++vb)
#pragma unroll
            for (int r = 0; r < 16; ++r) { const float v = o[vb][r] * inv - X[(rg * 64 + vb * 16 + r) * 64 + lane]; o[vb][r] = v; ss += v * v; if ((r & 3) == 3) asm volatile("" ::: "memory"); }
        ss += __shfl_xor(ss, 32);
        const float rs = oscale / sqrtf(ss * (1.0f / 128.0f) + 1e-5f);
        LAS unsigned char* stg = lds + 65536 + rg * 8704;
#pragma unroll
        for (int vb = 0; vb < 4; ++vb)
#pragma unroll
            for (int r4 = 0; r4 < 4; ++r4) { const int v0 = 32 * vb + 8 * r4 + 4 * hi; const f32x4 g4 = *(const f32x4*)(sg + v0);
                v2u w; w.x = cvtpk(o[vb][4 * r4] * rs * g4.x, o[vb][4 * r4 + 1] * rs * g4.y); w.y = cvtpk(o[vb][4 * r4 + 2] * rs * g4.z, o[vb][4 * r4 + 3] * rs * g4.w);
                *(LAS v2u*)(stg + r32 * 272 + v0 * 2) = w; asm volatile("" ::: "memory"); }
        asm volatile("s_waitcnt lgkmcnt(0)" ::: "memory");
#pragma unroll
        for (int i = 0; i < 8; ++i) { const int c = i * 64 + lane, row = c >> 4, chn = c & 15; const v4u v = *(LAS const v4u*)(stg + row * 272 + chn * 16);
            *(v4u*)(mix + (rowbase + q0 + row) * D + 1024 + h * 128 + chn * 8) = v; }
    }
    __syncthreads();
}

#define XB_TMO      128
#define XB_XCNT(j)  (256  + 64 * (j))
#define XB_XSUB(j)  (1280 + 64 * (j))
#define XB_XGEN(j)  (2304 + 64 * (j))
#define XB_TOP      3328
#define XB_TOPGEN   3392
#define XCD_BAR_WORDS 3456
#define XB_SPIN_CAP (1u << 18)

__device__ __forceinline__ unsigned xb_ld(unsigned* p)              { return __hip_atomic_load(p, __ATOMIC_RELAXED, __HIP_MEMORY_SCOPE_AGENT); }
__device__ __forceinline__ unsigned xb_add(unsigned* p, unsigned v) { return __hip_atomic_fetch_add(p, v, __ATOMIC_RELAXED, __HIP_MEMORY_SCOPE_AGENT); }
__device__ __forceinline__ unsigned xb_xcc_id() { return (unsigned)__builtin_amdgcn_s_getreg((3 << 11) | 20) & 0xFu; }
#define XB_SPIN(cond, bar) do { unsigned _sp = 0; while (cond) { __builtin_amdgcn_s_sleep(1); \
    if ((++_sp & 255u) == 0u) { if (xb_ld(&(bar)[XB_TMO])) break; if (_sp > XB_SPIN_CAP) { atomicAdd(&(bar)[XB_TMO], 1u); break; } } } } while (0)

struct XcdBarrier {
    unsigned* bar; unsigned x;
    volatile LAS unsigned* st;
};

__device__ __forceinline__ XcdBarrier xcd_barrier_post(unsigned* bar, volatile LAS unsigned* st) {
    XcdBarrier b; b.bar = bar; b.x = xb_xcc_id(); b.st = st;
    if (threadIdx.x == 0) (void)xb_add(&bar[XB_XCNT(b.x)], 1u);
    return b;
}
__device__ __forceinline__ void xcd_barrier_complete(unsigned* bar, unsigned x, unsigned& nloc, unsigned& nx) {
    const unsigned G = gridDim.x * gridDim.y * gridDim.z;
    unsigned sum, cnt, mine, sp = 0u;
    for (;;) {
        sum = 0u; cnt = 0u; mine = 0u;
#pragma unroll
        for (unsigned j = 0; j < 16; ++j) { const unsigned c = xb_ld(&bar[XB_XCNT(j)]); sum += c; cnt += (c > 0u) ? 1u : 0u; mine = (j == x) ? c : mine; }
        if (sum == G) break;
        __builtin_amdgcn_s_sleep(1);
        if ((++sp & 255u) == 0u) { if (xb_ld(&bar[XB_TMO])) break; if (sp > XB_SPIN_CAP) { atomicAdd(&bar[XB_TMO], 1u); break; } }
    }
    nloc = mine > 0u ? mine : 1u; nx = cnt > 0u ? cnt : 1u;
}

__device__ __forceinline__ void xcd_barrier(const XcdBarrier& b, const int tid) {
    asm volatile("s_waitcnt vmcnt(0)" ::: "memory");
    __syncthreads();
    if (tid == 0) {
        unsigned* bar = b.bar;
        __builtin_amdgcn_s_waitcnt(0);
        unsigned nloc = b.st[0], nx = b.st[1];
        if (nloc == 0u) { xcd_barrier_complete(bar, b.x, nloc, nx); b.st[0] = nloc; b.st[1] = nx; }
        const unsigned old = xb_add(&bar[XB_XSUB(b.x)], 1u);
        const unsigned gen = old / nloc;
        if (old + 1u == (gen + 1u) * nloc) {
            __builtin_amdgcn_fence(__ATOMIC_RELEASE, "agent");
            asm volatile("s_waitcnt vmcnt(0)" ::: "memory");
            const unsigned og = xb_add(&bar[XB_TOP], 1u);
            const unsigned tg = og / nx;
            if (og + 1u == (tg + 1u) * nx) xb_add(&bar[XB_TOPGEN], 1u);
            else XB_SPIN(xb_ld(&bar[XB_TOPGEN]) == tg, bar);
            __builtin_amdgcn_fence(__ATOMIC_ACQUIRE, "agent");
            xb_add(&bar[XB_XGEN(b.x)], 1u);
            asm volatile("s_waitcnt vmcnt(0)" ::: "memory");
        } else {
            XB_SPIN(xb_ld(&bar[XB_XGEN(b.x)]) == gen, bar);
            __builtin_amdgcn_fence(__ATOMIC_ACQUIRE, "agent");
            asm volatile("s_waitcnt vmcnt(0)" ::: "memory");
        }
    }
    __syncthreads();
}

__global__ void __launch_bounds__(512, 2) fwd_kernel(Args a) {
    extern __shared__ __attribute__((aligned(16))) unsigned char lds_raw[];
    LAS unsigned char* lds = (LAS unsigned char*)lds_raw;
    cg::grid_group grid = cg::this_grid();
    const int G = gridDim.x;
    const int wid0 = __builtin_amdgcn_readfirstlane((int)threadIdx.x >> 6);
    unsigned char* ws = a.ws;
    bf16* XBF = (bf16*)(ws + WS_XBF); bf16* PROJ = (bf16*)(ws + WS_PROJ); bf16* MIX = (bf16*)(ws + WS_MIX); bf16* Z = (bf16*)(ws + WS_Z); bf16* HB = (bf16*)(ws + WS_H);
    float* Y = (float*)(ws + WS_Y); float* S1 = (float*)(ws + WS_S1); float* S2 = (float*)(ws + WS_S2); const float* CD = (const float*)(ws + WS_CD);
    volatile LAS unsigned* MISC = (volatile LAS unsigned*)(lds + 146432);
    if (threadIdx.x < 32) MISC[threadIdx.x] = 0u;
    __syncthreads();
    const XcdBarrier xbar = xcd_barrier_post((unsigned*)(ws + WS_CTL) + 4096, MISC + 8);
    for (int ph = a.ph_lo; ph < a.ph_hi; ++ph) {
        if (a.ph_hi > 4096) grid.sync();
        if (ph > a.ph_lo) { int wq_ = wid0; unsigned ones_ = ~0u; asm volatile("" : "+s"(wq_), "+s"(ones_));
            xcd_barrier(xbar, wq_ * 64 + (int)__builtin_amdgcn_mbcnt_hi(ones_, __builtin_amdgcn_mbcnt_lo(ones_, 0u))); }
#ifdef REP_MASK
        const int kk_ = ph == 0 ? 8 : (ph == NPHASE - 1 ? 6 : ((ph - 1) % 6)); const int nrep = ((REP_MASK >> kk_) & 1) ? 2 : 1;
        for (int rep = 0; rep < nrep; ++rep) { if (rep) xcd_barrier(xbar, (int)threadIdx.x);
#endif
        int wq = wid0; unsigned ones = ~0u; asm volatile("" : "+s"(wq), "+s"(ones));
        int tid = wq * 64 + (int)__builtin_amdgcn_mbcnt_hi(ones, __builtin_amdgcn_mbcnt_lo(ones, 0u)); asm volatile("" : "+v"(tid));
        const int l = (ph - 1) / 6, k = (ph - 1) % 6;
        if (ph == 0) {
#ifndef NO_PRO
            prologue(a, lds, G, tid);
#endif
        } else if (ph == NPHASE - 1) {
#ifndef NO_LN
            ln_phase(Y, a.in[21] + (size_t)(DEPTH - 1) * D, a.in[22] + (size_t)(DEPTH - 1) * D, a.out, G, tid);
#endif
        } else if (k == 0 || k == 3) {
            const int N = (k == 0) ? INW : FF2;
            const bf16* Bt = (k == 0) ? (const bf16*)(ws + WS_WIN) + (size_t)l * INW * D : (const bf16*)(ws + WS_WUP) + (size_t)l * FF2 * D;
            pg8::Gemm g{XBF, Bt, T, N, D}; pg8::StaticOrder S; S.init(T, N, G, (int)blockIdx.x);
            pg8::EpiBf16Ln E{(k == 0) ? PROJ : Z, N, (k == 0) ? S2 : S1, CD + (size_t)l * 32768 + (k == 0 ? 0 : 10240), CD + (size_t)l * 32768 + (k == 0 ? 5120 : 21504), lds + 131072, (k == 0 && l == 0) ? 0 : 1};
            if ((tid & 63) == 0) *((LAS int*)(lds + 131072 + 14336) + (tid >> 6)) = -1;
#ifndef NO_GEMM1
            pg8::gemm_phase<pg8::EpiBf16Ln, pg8::StaticOrder, true, true>(lds, g, S, E, tid);
#endif
        } else if (k == 2 || k == 5) {
            const int K = (k == 2) ? D : FF;
            const bf16* A = (k == 2) ? MIX : HB;
            const bf16* Bt = (k == 2) ? (const bf16*)(ws + WS_WOUT) + (size_t)l * D * D : (const bf16*)(ws + WS_WDN) + (size_t)l * D * FF;
            const bool ln = !(k == 2 && l == 0);
            const int lg = (k == 2) ? l - 1 : l;
            const float* gg = ((k == 2) ? a.in[21] : a.in[15]) + (size_t)(ln ? lg : 0) * D; const float* bb = ((k == 2) ? a.in[22] : a.in[16]) + (size_t)(ln ? lg : 0) * D;
            pg8::Gemm g{A, Bt, T, D, K}; pg8::StaticOrder S; S.init(T, D, G, (int)blockIdx.x);
            const float* gn = (k == 2) ? a.in[15] + (size_t)l * D : a.in[21] + (size_t)l * D;
#ifdef REP_MASK
            const bool dmy = (nrep == 2 && rep == 0);
            pg8::EpiResLn E{ln ? (const float*)Y : a.in[0], dmy ? (float*)(ws + 420 * MiB) : Y, dmy ? (bf16*)(ws + 388 * MiB) : XBF, D, DN_ALPHA, (k == 2) ? S2 : S1, gg, bb, gn, dmy ? (float*)(ws + 484 * MiB) : ((k == 2) ? S1 : S2), lds + 131072, ln ? 1 : 0};
#else
            pg8::EpiResLn E{ln ? (const float*)Y : a.in[0], Y, XBF, D, DN_ALPHA, (k == 2) ? S2 : S1, gg, bb, gn, (k == 2) ? S1 : S2, lds + 131072, ln ? 1 : 0};
#endif
#ifndef NO_GEMM2
            pg8::gemm_phase<pg8::EpiResLn, pg8::StaticOrder, true, true>(lds, g, S, E, tid);
#endif
        } else if (k == 4) {
#ifndef NO_CONV
            convgelu_phase(Z, a.in[18] + (size_t)l * 3 * FF2, a.in[19] + (size_t)l * FF2, HB, G, tid);
#endif
        } else {
            const int lane = tid & 63;
            const float d1 = wave_sum(a.in[9][l * 64 + lane] * a.in[10][l * 64 + lane]), d2 = wave_sum(a.in[11][l * 64 + lane] * a.in[12][l * 64 + lane]);
            const float lam_init = 0.8f - 0.6f * __expf(-0.3f * (float)l);
            const float lam = __expf(d1) - __expf(d2) + lam_init;
            unsigned* masks = (unsigned*)(ws + WS_CTL) + 1024 + l * 256;
            if (l == 0) fold_phase(a, G, tid);
#ifndef NO_RG
            for (int item = blockIdx.x; item < 512; item += G)
                rg_item(lds, item, PROJ, MIX, (const bf16*)(ws + WS_GT) + (size_t)l * 16 * 2 * 4096, a.in[2] + (size_t)l * 4096, a.in[3] + (size_t)l * 1024,
                        a.in[5] + (size_t)l * 1024, a.in[7] + (size_t)l * 1024, a.in[8] + (size_t)l * 1024, masks, (unsigned long long*)(ws + WS_SUM), tid);
#endif
#ifndef NO_ATTN
            for (int p = blockIdx.x; p < 256; p += G) { const int bh = p >> 3, s = p & 7, b = bh >> 3, h = bh & 7;
                const float sl2 = ex2(-(float)(h + 1)) * LOG2E;
                attn_unit(lds, PROJ, MIX, b, h, 15 - s, lam, sl2, a.in[13] + (size_t)l * 128, 1.0f - lam_init, tid);
                attn_unit(lds, PROJ, MIX, b, h, s, lam, sl2, a.in[13] + (size_t)l * 128, 1.0f - lam_init, tid); }
#endif
        }
#ifdef REP_MASK
        }
#endif
    }
#ifdef REP_SYNC
    for (int i = 0; i < REP_SYNC; ++i) xcd_barrier(xbar, (int)threadIdx.x);
#endif
}

extern "C" void kernel_launch(void* const* d_in, const int* in_sizes, int n_in, void* d_out, int out_size, void* d_ws, size_t ws_size, hipStream_t stream) {
    static int grid = 0;
    if (grid == 0) {
        if (n_in != 23 || in_sizes[0] != T * D || out_size != T * D || ws_size < WS_END) { fprintf(stderr, "kernel_launch: unexpected shapes (n_in %d, in0 %d, out %d, ws %zu)\n", n_in, n_in > 0 ? in_sizes[0] : -1, out_size, ws_size); grid = -1; return; }
        int dev = 0, cus = 0, per_cu = 0;
        hipGetDevice(&dev); hipDeviceGetAttribute(&cus, hipDeviceAttributeMultiprocessorCount, dev);
        if (hipFuncSetAttribute((const void*)fwd_kernel, hipFuncAttributeMaxDynamicSharedMemorySize, LDS_BYTES) != hipSuccess) { fprintf(stderr, "kernel_launch: hipFuncSetAttribute failed\n"); grid = -1; return; }
        if (hipOccupancyMaxActiveBlocksPerMultiprocessor(&per_cu, (const void*)fwd_kernel, 512, LDS_BYTES) != hipSuccess || per_cu < 1) { fprintf(stderr, "kernel_launch: occupancy query failed (%d)\n", per_cu); per_cu = 1; }
        (void)hipGetLastError();
        grid = cus * per_cu;
        fprintf(stderr, "kernel_launch: grid %d (cus %d x %d)\n", grid, cus, per_cu);
    }
    if (grid < 0) return;
    hipMemsetAsync((char*)d_ws + WS_CTL, 0, CTL_BYTES, stream);
    Args a{};
    for (int i = 0; i < 23; ++i) a.in[i] = (const float*)d_in[i];
    a.out = (float*)d_out; a.ws = (unsigned char*)d_ws;
#ifndef MK_SPLIT
    a.ph_lo = 0; a.ph_hi = NPHASE;
    void* args[] = {&a};
    hipError_t e = hipLaunchCooperativeKernel((const void*)fwd_kernel, dim3(grid), dim3(512), args, LDS_BYTES, stream);
    if (e != hipSuccess) fprintf(stderr, "cooperative launch failed: %s (grid %d)\n", hipGetErrorString(e), grid);
#else
    for (int ph = 0; ph < NPHASE; ++ph) { a.ph_lo = ph; a.ph_hi = ph + 1; void* args[] = {&a};
        hipError_t e = hipLaunchCooperativeKernel((const void*)fwd_kernel, dim3(grid), dim3(512), args, LDS_BYTES, stream);
        if (e != hipSuccess) { fprintf(stderr, "cooperative launch %d failed: %s (grid %d)\n", ph, hipGetErrorString(e), grid); break; } }
#endif
}
```

```cpp
#include <hip/hip_runtime.h>
#include <hip/hip_cooperative_groups.h>
#include <cstdio>
#include <cstdint>
namespace pg8 {
#define PG8_LAS __attribute__((address_space(3)))
typedef unsigned short bf16_t;
typedef short bf16x8 __attribute__((ext_vector_type(8)));
typedef float f32x4 __attribute__((ext_vector_type(4)));
typedef unsigned u32x4 __attribute__((ext_vector_type(4)));
constexpr int BM = 256, BK = 64, HALF = 128, HTB = HALF * BK * 2  , STAGE_BYTES = 8 * HTB, NXCD = 8, WGM = 8;

__host__ __device__ __forceinline__ int lds_byte(int r, int c) { const int st = (r >> 4) * 2 + (c >> 5), rr = r & 15, cc = c & 31, ob = rr * 64 + cc * 2; return st * 1024 + (ob ^ (((ob >> 9) & 1) << 5)); }
__host__ __device__ __forceinline__ void stage_rc(int b, int& R, int& C) { const int st = b / 1024, sb = b % 1024, swz = sb ^ (((sb >> 9) & 1) << 5); R = (st >> 1) * 16 + swz / 64; C = (st & 1) * 32 + (swz % 64) / 2; }
__host__ __device__ __forceinline__ int perm32(int rho) { const int n = rho >> 4, i = rho & 15; return 8 * (i >> 2) + 4 * n + (i & 3); }

struct Unit { int pm, pn; };
struct Gemm { const bf16_t* A; const bf16_t* Bt; int M, N, K; };

struct StaticOrder {
    int nM, nN, nwg, G, c;
    __host__ __device__ void init(int M, int N, int G_, int c_) { nM = M / BM; nN = N / BM; nwg = nM * nN; G = G_; c = c_; }
    __host__ __device__ bool next(int i, Unit& u) const {
        const long L = (long)i * G + c; if (L >= nwg) return false;
        int wgid = (int)L; { const int q = nwg / NXCD, r = nwg % NXCD, xcd = wgid % NXCD, off = wgid / NXCD; wgid = (xcd < r ? xcd * (q + 1) : r * (q + 1) + (xcd - r) * q) + off; }
        const int nig = WGM * nN, gid = wgid / nig, fm = gid * WGM, gsz = (nM - fm) < WGM ? (nM - fm) : WGM;
        u.pm = fm + ((wgid % nig) % gsz); u.pn = (wgid % nig) / gsz; return true;
    }
    __device__ __forceinline__ void a_ready(const Unit&) const {}
    __device__ __forceinline__ void done(const Unit&) const {}
};

typedef float cvt_f32x2_t __attribute__((ext_vector_type(2))); typedef __bf16 cvt_bf16x2_t __attribute__((ext_vector_type(2)));
__device__ __forceinline__ unsigned cvt_pk_bf16(float lo, float hi) { cvt_f32x2_t v = {lo, hi}; cvt_bf16x2_t b = __builtin_convertvector(v, cvt_bf16x2_t); return __builtin_bit_cast(unsigned, b); }
typedef float f32x2 __attribute__((ext_vector_type(2)));
__device__ __forceinline__ f32x2 gelu_pk(f32x2 v) {
    const f32x2 av = __builtin_elementwise_abs(v), d = av * 0.2316418882f + 1.0f;
    f32x2 t; t.x = __builtin_amdgcn_rcpf(d.x); t.y = __builtin_amdgcn_rcpf(d.y);
    f32x2 q = t * 0.5307027145f + (-0.7265760135f); q = q * t + 0.7107068705f; q = q * t + (-0.142248368f); q = q * t + 0.127414796f; q = q * t;
    const f32x2 s = (v * v) * (-0.72134752044f);
    f32x2 e; e.x = __builtin_amdgcn_exp2f(s.x); e.y = __builtin_amdgcn_exp2f(s.y);
    const f32x2 m = v * (q * e), r = v - m;
    f32x2 o; o.x = v.x < 0.f ? m.x : r.x; o.y = v.y < 0.f ? m.y : r.y; return o;
}

template <int ACT  > struct EpiBf16 {
    static constexpr bool PERM = true, AFTER_DRAIN = false; static_assert(ACT == 0 || ACT == 1, "EpiBf16: ACT is 0 (none) or 1 (gelu_pk)");
    bf16_t* O; int ldc; const float* bias; int split_cols; size_t split_stride; float scale0;
    __device__ __forceinline__ void operator()(const f32x4 (&acc)[2][2][4][2], const Unit& u, int wr, int wc, int fr, int fq) const {
        const int row0 = u.pm * BM + wr * 64 + fr; int colt = u.pn * BM; bf16_t* base = O;
        float sc = 1.f; if (split_cols) { const int t = colt / split_cols; base += (size_t)t * split_stride; colt -= t * split_cols; if (t == 0) sc = scale0; }
        const int col0 = colt + wc * 32 + 8 * fq, bcol0 = u.pn * BM + wc * 32 + 8 * fq;
        f32x4 bv[2][2];
#pragma unroll
        for (int bj = 0; bj < 2; ++bj)
#pragma unroll
            for (int n = 0; n < 2; ++n) bv[bj][n] = bias ? *(const f32x4*)(bias + bcol0 + bj * HALF + 4 * n) : (f32x4){0.f, 0.f, 0.f, 0.f};
#pragma unroll
        for (int ai = 0; ai < 2; ++ai)
#pragma unroll
            for (int m = 0; m < 4; ++m) { bf16_t* rowp = base + (size_t)(row0 + ai * HALF + m * 16) * ldc + col0;
#pragma unroll
                for (int bj = 0; bj < 2; ++bj) { f32x4 v0 = acc[ai][bj][m][0] + bv[bj][0], v1 = acc[ai][bj][m][1] + bv[bj][1];
                    if (ACT == 1) { f32x2 a = gelu_pk((f32x2){v0[0], v0[1]}), b = gelu_pk((f32x2){v0[2], v0[3]}), c = gelu_pk((f32x2){v1[0], v1[1]}), d = gelu_pk((f32x2){v1[2], v1[3]});
                        v0 = (f32x4){a.x, a.y, b.x, b.y}; v1 = (f32x4){c.x, c.y, d.x, d.y}; }
                    v0 = v0 * sc; v1 = v1 * sc; u32x4 w; w.x = cvt_pk_bf16(v0[0], v0[1]); w.y = cvt_pk_bf16(v0[2], v0[3]); w.z = cvt_pk_bf16(v1[0], v1[1]); w.w = cvt_pk_bf16(v1[2], v1[3]);
                    *(u32x4*)(rowp + bj * HALF) = w; } }
    }
};
constexpr int SSTR = 8192 + 32;
__device__ __forceinline__ void row_stats_table(const float* S, int pm, int wr, int lane, PG8_LAS float* tab) {
    const int half = lane >> 5, rl = (lane & 31) * 2;
    const f32x4* sp = (const f32x4*)((const f32x2*)S + (size_t)(pm * BM + half * HALF + wr * 64 + rl));
    float s0 = 0.f, q0 = 0.f, s1 = 0.f, q1 = 0.f;
#pragma unroll
    for (int b = 0; b < 4; ++b) { f32x4 v[8];
#pragma unroll
        for (int i = 0; i < 8; ++i) v[i] = sp[(size_t)(b * 8 + i) * (SSTR / 2)];
        asm volatile("" : "+v"(v[0]), "+v"(v[1]), "+v"(v[2]), "+v"(v[3]), "+v"(v[4]), "+v"(v[5]), "+v"(v[6]), "+v"(v[7]));
#pragma unroll
        for (int i = 0; i < 8; ++i) { s0 += v[i][0]; q0 += v[i][1]; s1 += v[i][2]; q1 += v[i][3]; } }
    const float m0 = s0 * (1.0f / 2048.0f), m1 = s1 * (1.0f / 2048.0f);
    f32x4 t; t[0] = m0; t[1] = 1.0f / sqrtf(q0 * (1.0f / 2048.0f) - m0 * m0 + 1e-5f); t[2] = m1; t[3] = 1.0f / sqrtf(q1 * (1.0f / 2048.0f) - m1 * m1 + 1e-5f);
    *(PG8_LAS f32x4*)(tab + (half * 64 + rl) * 2) = t;
    asm volatile("s_waitcnt lgkmcnt(0)" ::: "memory");
}
struct EpiBf16Ln {
    static constexpr bool PERM = true, AFTER_DRAIN = false;
    bf16_t* O; int ldc; const float* S; const float* cvec; const float* dvec; PG8_LAS unsigned char* ltab; int ln;
    __device__ __forceinline__ void operator()(const f32x4 (&acc)[2][2][4][2], const Unit& u, int wr, int wc, int fr, int fq) const {
        const int row0 = u.pm * BM + wr * 64 + fr, col0 = u.pn * BM + wc * 32 + 8 * fq;
        PG8_LAS float* tab = (PG8_LAS float*)(ltab + (wr * 4 + wc) * 1024);
        f32x4 cv[2][2], dv[2][2];
        if (ln) { PG8_LAS int* tag = (PG8_LAS int*)(ltab + 14336) + (wr * 4 + wc);
            if (__builtin_amdgcn_readfirstlane(*tag) != u.pm) { row_stats_table(S, u.pm, wr, fq * 16 + fr, tab); *tag = u.pm; }
#pragma unroll
            for (int bj = 0; bj < 2; ++bj)
#pragma unroll
                for (int n = 0; n < 2; ++n) { cv[bj][n] = *(const f32x4*)(cvec + col0 + bj * HALF + 4 * n); dv[bj][n] = *(const f32x4*)(dvec + col0 + bj * HALF + 4 * n); } }
#pragma unroll
        for (int ai = 0; ai < 2; ++ai)
#pragma unroll
            for (int m = 0; m < 4; ++m) { bf16_t* rowp = O + (size_t)(row0 + ai * HALF + m * 16) * ldc + col0;
                float rs = 1.f, t = 0.f; if (ln) { const float mu = tab[(ai * 64 + m * 16 + fr) * 2]; rs = tab[(ai * 64 + m * 16 + fr) * 2 + 1]; t = -rs * mu; }
#pragma unroll
                for (int bj = 0; bj < 2; ++bj) { f32x4 v0 = acc[ai][bj][m][0], v1 = acc[ai][bj][m][1];
                    if (ln) { v0 = v0 * rs + (cv[bj][0] * t + dv[bj][0]); v1 = v1 * rs + (cv[bj][1] * t + dv[bj][1]); }
                    u32x4 w; w.x = cvt_pk_bf16(v0[0], v0[1]); w.y = cvt_pk_bf16(v0[2], v0[3]); w.z = cvt_pk_bf16(v1[0], v1[1]); w.w = cvt_pk_bf16(v1[2], v1[3]);
                    *(u32x4*)(rowp + bj * HALF) = w; } }
    }
};
struct EpiResLn {
    static constexpr bool PERM = false, AFTER_DRAIN = false;
    const float* base; float* Y; bf16_t* YB; int ldc; float alpha; const float* Sin; const float* g; const float* b; const float* gn; float* So; PG8_LAS unsigned char* ltab; int ln;
    __device__ __forceinline__ void operator()(const f32x4 (&acc)[2][2][4][2], const Unit& u, int wr, int wc, int fr, int fq) const {
        const int row0 = u.pm * BM + wr * 64 + fr, col0 = u.pn * BM + wc * 32 + 4 * fq;
        PG8_LAS float* tab = (PG8_LAS float*)(ltab + (wr * 4 + wc) * 1024);
        PG8_LAS float* cvl = (PG8_LAS float*)(ltab + 8192 + (wr * 4 + wc) * 768);
        { const int lane = fq * 16 + fr, gc = u.pn * BM + (lane >> 5) * HALF + wc * 32 + (lane & 31); cvl[lane] = g[gc]; cvl[64 + lane] = b[gc]; cvl[128 + lane] = gn[gc]; }
        if (ln) row_stats_table(Sin, u.pm, wr, fq * 16 + fr, tab);
        f32x4 xb[3][2][2];
#pragma unroll
        for (int pr = 0; pr < 2; ++pr)
#pragma unroll
            for (int bj = 0; bj < 2; ++bj)
#pragma unroll
                for (int n = 0; n < 2; ++n) xb[pr][bj][n] = *(const f32x4*)(base + (size_t)(row0 + pr * 16) * ldc + col0 + bj * HALF + n * 16);
#pragma unroll
        for (int ai = 0; ai < 2; ++ai)
#pragma unroll
            for (int m = 0; m < 4; ++m) { const int ri = ai * 4 + m, row = row0 + ai * HALF + m * 16; const size_t off = (size_t)row * ldc + col0;
                if (ri < 6) { const int nrow = row0 + ((ri + 2) >> 2) * HALF + ((ri + 2) & 3) * 16;
#pragma unroll
                    for (int bj = 0; bj < 2; ++bj)
#pragma unroll
                        for (int n = 0; n < 2; ++n) xb[(ri + 2) % 3][bj][n] = *(const f32x4*)(base + (size_t)nrow * ldc + col0 + bj * HALF + n * 16); }
                float mu = 0.f, rs = 1.f; if (ln) { mu = tab[(ai * 64 + m * 16 + fr) * 2]; rs = tab[(ai * 64 + m * 16 + fr) * 2 + 1]; }
                float s = 0.f, q = 0.f;
#pragma unroll
                for (int bj = 0; bj < 2; ++bj)
#pragma unroll
                    for (int n = 0; n < 2; ++n) { f32x4 x = xb[ri % 3][bj][n]; const int ci = bj * 32 + n * 16 + 4 * fq;
                        if (ln) x = (x - mu) * rs * *(const PG8_LAS f32x4*)(cvl + ci) + *(const PG8_LAS f32x4*)(cvl + 64 + ci);
                        const f32x4 o = x * alpha + acc[ai][bj][m][n];
                        *(f32x4*)(Y + off + bj * HALF + n * 16) = o;
                        const f32x4 og = o * *(const PG8_LAS f32x4*)(cvl + 128 + ci);
                        unsigned w0 = cvt_pk_bf16(og[0], og[1]), w1 = cvt_pk_bf16(og[2], og[3]);
                        *(unsigned long long*)(YB + off + bj * HALF + n * 16) = ((unsigned long long)w1 << 32) | w0;
                        s += (o[0] + o[1]) + (o[2] + o[3]); q += (o[0] * o[0] + o[1] * o[1]) + (o[2] * o[2] + o[3] * o[3]); }
                s += __shfl_xor(s, 16); s += __shfl_xor(s, 32); q += __shfl_xor(q, 16); q += __shfl_xor(q, 32);
                if (fq == 0) { f32x2 sq; sq[0] = s; sq[1] = q; ((f32x2*)So)[(size_t)(u.pn * 4 + wc) * SSTR + row] = sq; } }
    }
};
template <class Epi, class Sched, bool ALIGN_EPI = false, bool SP2 = false>
__device__ __forceinline__ void gemm_phase(PG8_LAS unsigned char* lds, const Gemm g, const Sched& S, const Epi& E, const int tid_in) {
    const int tid = tid_in, wid = __builtin_amdgcn_readfirstlane(tid >> 6), lane = tid & 63, wr = wid >> 2, wc = wid & 3, fr = lane & 15, fq = lane >> 4;
    const int K = g.K, nt = K / BK;
    unsigned voffA[2], voffB[2];
#pragma unroll
    for (int i = 0; i < 2; ++i) { int R, C; stage_rc(tid * 16 + i * 8192, R, C); const int Rb = Epi::PERM ? ((R & ~31) + perm32(R & 31)) : R;
        voffA[i] = (unsigned)(R * K + C) * 2u; voffB[i] = (unsigned)(Rb * K + C) * 2u; }
    const size_t kstep = (size_t)(BK * 2);
    const size_t hstep = (size_t)HALF * K * 2;
    const size_t tstep = 2 * hstep;
    const unsigned ldsw = (unsigned)wid * 1024u;
    const int aoff = lds_byte(wr * 64 + fr, fq * 8), boff = lds_byte(wc * 32 + fr, fq * 8);
#define PG8_SA(b, h) (((b) * 2 + (h)) * HTB)
#define PG8_SB(b, h) ((4 + (b) * 2 + (h)) * HTB)
#define PG8_STAGE(bufoff, gbase, voff) do { _Pragma("unroll") for (int _i = 0; _i < 2; ++_i) \
        __builtin_amdgcn_global_load_lds((const unsigned*)((const char*)(gbase) + (voff)[_i]), (PG8_LAS unsigned*)(lds + (bufoff) + ldsw + _i * 8192), 16, 0, 0); } while (0)
#define PG8_LDA(dst, b, h) do { _Pragma("unroll") for (int m = 0; m < 4; ++m) _Pragma("unroll") for (int k = 0; k < 2; ++k) dst[m][k] = *(const PG8_LAS bf16x8*)(lds + PG8_SA(b, h) + aoff + m * 2048 + k * 1024); } while (0)
#define PG8_LDB(dst, b, h) do { _Pragma("unroll") for (int n = 0; n < 2; ++n) _Pragma("unroll") for (int k = 0; k < 2; ++k) dst[n][k] = *(const PG8_LAS bf16x8*)(lds + PG8_SB(b, h) + boff + n * 2048 + k * 1024); } while (0)
#define PG8_MMA(ai, bj, At, Bt) do { __builtin_amdgcn_s_setprio(1); _Pragma("unroll") for (int m = 0; m < 4; ++m) _Pragma("unroll") for (int n = 0; n < 2; ++n) _Pragma("unroll") for (int k = 0; k < 2; ++k) \
        acc[ai][bj][m][n] = __builtin_amdgcn_mfma_f32_16x16x32_bf16(Bt[n][k], At[m][k], acc[ai][bj][m][n], 0, 0, 0); __builtin_amdgcn_s_setprio(0); } while (0)
#define PG8_WAIT_V(n) asm volatile("s_waitcnt vmcnt(" #n ")" ::: "memory")
#define PG8_WAIT_L(n) asm volatile("s_waitcnt lgkmcnt(" #n ")" ::: "memory")
#define PG8_BAR __builtin_amdgcn_s_barrier()
#define PG8_SCHED __builtin_amdgcn_sched_barrier(0)
    Unit cur, nxt; int ui = 0;
    if (!S.next(0, cur)) return;
    f32x4 acc[2][2][4][2];
#pragma unroll
    for (int a = 0; a < 2; ++a)
#pragma unroll
        for (int b = 0; b < 2; ++b)
#pragma unroll
            for (int m = 0; m < 4; ++m)
#pragma unroll
                for (int n = 0; n < 2; ++n) acc[a][b][m][n] = (f32x4){0.f, 0.f, 0.f, 0.f};
    bf16x8 At[4][2], B0[2][2], B1[2][2];
    const char* cA = (const char*)g.A + (size_t)cur.pm * tstep; const char* cB = (const char*)g.Bt + (size_t)cur.pn * tstep;
    S.a_ready(cur);
    if constexpr (SP2) {
        PG8_STAGE(PG8_SB(0, 0), cB, voffB); PG8_STAGE(PG8_SB(0, 1), cB + hstep, voffB); PG8_STAGE(PG8_SA(0, 0), cA, voffA); PG8_STAGE(PG8_SA(0, 1), cA + hstep, voffA);
        if (wr == 1) PG8_BAR;
        PG8_WAIT_V(2); PG8_BAR;
        PG8_STAGE(PG8_SB(1, 0), cB + kstep, voffB); PG8_STAGE(PG8_SA(1, 0), cA + kstep, voffA); PG8_STAGE(PG8_SB(1, 1), cB + hstep + kstep, voffB);
        PG8_WAIT_V(6); PG8_BAR;
    } else {
        PG8_STAGE(PG8_SB(0, 0), cB, voffB); PG8_STAGE(PG8_SA(0, 0), cA, voffA); PG8_STAGE(PG8_SB(0, 1), cB + hstep, voffB); PG8_STAGE(PG8_SA(0, 1), cA + hstep, voffA);
        if (wr == 1) PG8_BAR;
        PG8_WAIT_V(4); PG8_BAR;
        PG8_STAGE(PG8_SB(1, 0), cB + kstep, voffB); PG8_STAGE(PG8_SA(1, 0), cA + kstep, voffA); PG8_STAGE(PG8_SB(1, 1), cB + hstep + kstep, voffB);
        PG8_WAIT_V(6); PG8_BAR;
    }
    for (;;) {
        const bool has_next = S.next(ui + 1, nxt);
        const char* nA = has_next ? (const char*)g.A + (size_t)nxt.pm * tstep : cA; const char* nB = has_next ? (const char*)g.Bt + (size_t)nxt.pn * tstep : cB;
        for (int t = 0; t < nt; t += 2) {
            const bool last = (t == nt - 2);
            const char* a1 = cA + (size_t)(t + 1) * kstep;
            const char* a2 = last ? nA : cA + (size_t)(t + 2) * kstep; const char* b2 = last ? nB : cB + (size_t)(t + 2) * kstep;
            const char* a3 = a2 + kstep; const char* b3 = b2 + kstep;
            if (last && has_next) S.a_ready(nxt);
            if constexpr (SP2) {
            PG8_LDB(B0, 0, 0); PG8_LDB(B1, 0, 1); PG8_SCHED; PG8_LDA(At, 0, 0); PG8_STAGE(PG8_SA(1, 1), a1 + hstep, voffA);
            PG8_WAIT_V(8); PG8_WAIT_L(0); PG8_BAR; PG8_MMA(0, 0, At, B0); PG8_MMA(0, 1, At, B1); PG8_BAR; PG8_SCHED;
            PG8_LDA(At, 0, 1); PG8_STAGE(PG8_SB(0, 0), b2, voffB); PG8_STAGE(PG8_SB(0, 1), b2 + hstep, voffB); PG8_STAGE(PG8_SA(0, 0), a2, voffA);
            PG8_WAIT_V(8); PG8_WAIT_L(0); PG8_BAR; PG8_MMA(1, 0, At, B0); PG8_MMA(1, 1, At, B1); PG8_BAR; PG8_SCHED;
            PG8_LDB(B0, 1, 0); PG8_LDB(B1, 1, 1); PG8_SCHED; PG8_LDA(At, 1, 0); PG8_STAGE(PG8_SA(0, 1), a2 + hstep, voffA);
            PG8_WAIT_V(8); PG8_WAIT_L(0); PG8_BAR; PG8_MMA(0, 0, At, B0); PG8_MMA(0, 1, At, B1); PG8_BAR; PG8_SCHED;
            PG8_LDA(At, 1, 1); PG8_STAGE(PG8_SB(1, 0), b3, voffB); PG8_STAGE(PG8_SB(1, 1), b3 + hstep, voffB); PG8_STAGE(PG8_SA(1, 0), a3, voffA);
            PG8_WAIT_V(8); PG8_WAIT_L(0); PG8_BAR; PG8_MMA(1, 0, At, B0); PG8_MMA(1, 1, At, B1); PG8_BAR; PG8_SCHED;
            } else {
            PG8_LDB(B0, 0, 0); PG8_SCHED; PG8_LDA(At, 0, 0); PG8_STAGE(PG8_SA(1, 1), a1 + hstep, voffA);
            PG8_WAIT_L(8); PG8_BAR; PG8_WAIT_L(0); PG8_MMA(0, 0, At, B0); PG8_BAR; PG8_SCHED;
            PG8_LDB(B1, 0, 1); PG8_STAGE(PG8_SB(0, 0), b2, voffB);
            PG8_BAR; PG8_WAIT_L(0); PG8_MMA(0, 1, At, B1); PG8_BAR;
            PG8_LDA(At, 0, 1); PG8_STAGE(PG8_SA(0, 0), a2, voffA);
            PG8_BAR; PG8_WAIT_L(0); PG8_MMA(1, 0, At, B0); PG8_BAR; PG8_SCHED;
            PG8_STAGE(PG8_SB(0, 1), b2 + hstep, voffB);
            PG8_WAIT_V(6); PG8_BAR; PG8_MMA(1, 1, At, B1); PG8_BAR;
            PG8_LDB(B0, 1, 0); PG8_SCHED; PG8_LDA(At, 1, 0); PG8_STAGE(PG8_SA(0, 1), a2 + hstep, voffA);
            PG8_WAIT_L(8); PG8_BAR; PG8_WAIT_L(0); PG8_MMA(0, 0, At, B0); PG8_BAR; PG8_SCHED;
            PG8_LDB(B1, 1, 1); PG8_STAGE(PG8_SB(1, 0), b3, voffB);
            PG8_BAR; PG8_WAIT_L(0); PG8_MMA(0, 1, At, B1); PG8_BAR;
            PG8_LDA(At, 1, 1); PG8_STAGE(PG8_SA(1, 0), a3, voffA);
            PG8_BAR; PG8_WAIT_L(0); PG8_MMA(1, 0, At, B0); PG8_BAR; PG8_SCHED;
            PG8_STAGE(PG8_SB(1, 1), b3 + hstep, voffB);
            PG8_WAIT_V(6); PG8_BAR; PG8_MMA(1, 1, At, B1); PG8_BAR;
            }
        }
        if constexpr (ALIGN_EPI) { if (wr == 0) PG8_BAR; }
        if constexpr (!Epi::AFTER_DRAIN) { E(acc, cur, wr, wc, fr, fq); S.done(cur); }
        if (!has_next) break;
#pragma unroll
        for (int a = 0; a < 2; ++a)
#pragma unroll
            for (int b = 0; b < 2; ++b)
#pragma unroll
                for (int m = 0; m < 4; ++m)
#pragma unroll
                    for (int n = 0; n < 2; ++n) acc[a][b][m][n] = (f32x4){0.f, 0.f, 0.f, 0.f};
        cur = nxt; cA = nA; cB = nB; ++ui;
        if constexpr (ALIGN_EPI) { if (wr == 1) PG8_BAR; }
    }
    PG8_WAIT_V(0);
    if constexpr (!ALIGN_EPI) { if (wr == 0) PG8_BAR; }
    PG8_BAR;
    if constexpr (Epi::AFTER_DRAIN) { E.fused(acc, cur, wr, wc, fr, fq, lds, wid, lane); S.done(cur); }
#undef PG8_SA
#undef PG8_SB
#undef PG8_STAGE
#undef PG8_LDA
#undef PG8_LDB
#undef PG8_MMA
#undef PG8_WAIT_V
#undef PG8_WAIT_L
#undef PG8_BAR
#undef PG8_SCHED
}
}
namespace cg = cooperative_groups;
#define LAS __attribute__((address_space(3)))
typedef unsigned short bf16;
typedef unsigned v4u __attribute__((ext_vector_type(4)));
typedef unsigned v2u __attribute__((ext_vector_type(2)));
typedef float f32x4 __attribute__((ext_vector_type(4)));
typedef float f32x16 __attribute__((ext_vector_type(16)));
typedef short bf16x8 __attribute__((ext_vector_type(8)));
typedef short s16x4 __attribute__((ext_vector_type(4)));

constexpr int T = 8192, SEQ = 2048, D = 2048, INW = 5120, FF = 5632, FF2 = 11264, DEPTH = 4;
constexpr int NPHASE = 2 + 6 * DEPTH;
constexpr float LOG2E = 1.4426950408889634f;
constexpr float DN_ALPHA = 1.681792830507429f;
constexpr size_t MiB = 1u << 20;
constexpr size_t WS_CTL = 0, CTL_BYTES = 1 * MiB, WS_SUM = 1 * MiB, WS_GT = 2 * MiB, WS_WIN = 4 * MiB, WS_WOUT = 84 * MiB, WS_WUP = 116 * MiB, WS_WDN = 292 * MiB,
                 WS_S1 = 404 * MiB, WS_S2 = 408 * MiB, WS_CD = 384 * MiB, WS_PCD = 386 * MiB, WS_Y = 508 * MiB, WS_XBF = 572 * MiB, WS_PROJ = 604 * MiB, WS_MIX = 684 * MiB, WS_Z = 716 * MiB, WS_H = 892 * MiB, WS_END = 980 * MiB;
constexpr int LDS_BYTES = 147456;

__device__ __forceinline__ unsigned cvtpk(float lo, float hi) { return pg8::cvt_pk_bf16(lo, hi); }
__device__ __forceinline__ float bf2f(bf16 v) { return __uint_as_float((unsigned)v << 16); }
__device__ __forceinline__ float bflo(unsigned w) { return __uint_as_float(w << 16); }
__device__ __forceinline__ float bfhi(unsigned w) { return __uint_as_float(w & 0xffff0000u); }
__device__ __forceinline__ float ex2(float x) { return __builtin_amdgcn_exp2f(x); }
__device__ __forceinline__ float rcp(float x) { return __builtin_amdgcn_rcpf(x); }
__device__ __forceinline__ float sigmoidf_(float x) { return rcp(1.0f + ex2(-LOG2E * x)); }
__device__ __forceinline__ float gelu_tanh(float x) { const float y = x * (1.0f + 0.044715f * x * x); return x * rcp(1.0f + ex2(-2.0f * 0.7978845608028654f * LOG2E * y)); }
__device__ __forceinline__ float wave_sum(float v) {
#pragma unroll
    for (int o = 1; o < 64; o <<= 1) v += __shfl_xor(v, o);
    return v;
}

__device__ __forceinline__ void transpose_item(const float* __restrict__ W, int K, int N, bf16* __restrict__ WT, LAS float* scr, int item, int lane) {
    const int nblk = N / 32, kb = item / nblk, nb = item % nblk, k0 = 64 * kb, n0 = 32 * nb;
    const float* Wb = W + (size_t)k0 * N + n0; const unsigned loff = (unsigned)(lane >> 5) * (unsigned)N + (unsigned)(lane & 31);
#pragma unroll 8
    for (int i = 0; i < 32; ++i) { const int kk = 2 * i + (lane >> 5); scr[kk * 33 + (lane & 31)] = (Wb + (size_t)(2 * i) * N)[loff]; }
    asm volatile("s_waitcnt lgkmcnt(0)" ::: "memory");
    const int c = lane & 7;
#pragma unroll
    for (int j = 0; j < 4; ++j) { const int n = (lane >> 3) + 8 * j; const LAS float* s = scr + (8 * c) * 33 + n;
        v4u o; o.x = cvtpk(s[0 * 33], s[1 * 33]); o.y = cvtpk(s[2 * 33], s[3 * 33]); o.z = cvtpk(s[4 * 33], s[5 * 33]); o.w = cvtpk(s[6 * 33], s[7 * 33]);
        *(v4u*)(WT + (size_t)(n0 + n) * K + k0 + 8 * c) = o; }
    asm volatile("s_waitcnt lgkmcnt(0)" ::: "memory");
}

__device__ __forceinline__ void fold_rows(const bf16* __restrict__ Wt, const float* __restrict__ g, const float* __restrict__ b, float* __restrict__ c, float* __restrict__ d, int r0, int r1, int lane) {
    float gr[4][8], br[4][8];
#pragma unroll
    for (int j = 0; j < 4; ++j) { const f32x4 g0 = *(const f32x4*)(g + 512 * j + 8 * lane), g1 = *(const f32x4*)(g + 512 * j + 8 * lane + 4), b0 = *(const f32x4*)(b + 512 * j + 8 * lane), b1 = *(const f32x4*)(b + 512 * j + 8 * lane + 4);
#pragma unroll
        for (int e = 0; e < 4; ++e) { gr[j][e] = g0[e]; gr[j][4 + e] = g1[e]; br[j][e] = b0[e]; br[j][4 + e] = b1[e]; } }
    for (int r = r0; r < r1; ++r) { const v4u* wp = (const v4u*)(Wt + (size_t)r * D) + lane; v4u w[4];
#pragma unroll
        for (int j = 0; j < 4; ++j) w[j] = wp[64 * j];
        float cs = 0.f, ds = 0.f;
#pragma unroll
        for (int j = 0; j < 4; ++j)
#pragma unroll
            for (int e = 0; e < 4; ++e) { const float lo = bflo(w[j][e]), hi = bfhi(w[j][e]); cs += gr[j][2 * e] * lo + gr[j][2 * e + 1] * hi; ds += br[j][2 * e] * lo + br[j][2 * e + 1] * hi; }
        cs = wave_sum(cs); ds = wave_sum(ds);
        if (lane == 0) { c[r] = cs; d[r] = ds; } }
}
struct Args { const float* in[23]; float* out; unsigned char* ws; int ph_lo, ph_hi; };

__device__ __forceinline__ void prologue(const Args& a, LAS unsigned char* lds, int G, const int tid_in) {
    const int tid = tid_in, lane = tid & 63, wave = __builtin_amdgcn_readfirstlane(tid >> 6);
    LAS float* scr = (LAS float*)(lds + wave * 16384);
    const int gw = blockIdx.x * 8 + wave, NGW = G * 8;
    unsigned char* ws = a.ws;
    constexpr int I_IN = 32 * 160, I_OUT = 32 * 64, I_UP = 32 * 352, I_DN = 88 * 64, I_L = I_IN + I_OUT + I_UP + I_DN;
    for (int it = gw; it < DEPTH * I_L; it += NGW) {
        const int l = it / I_L; int r = it % I_L;
        if (r < I_IN) { transpose_item(a.in[1] + (size_t)l * D * INW, D, INW, (bf16*)(ws + WS_WIN) + (size_t)l * INW * D, scr, r, lane); continue; } r -= I_IN;
        if (r < I_OUT) { transpose_item(a.in[14] + (size_t)l * D * D, D, D, (bf16*)(ws + WS_WOUT) + (size_t)l * D * D, scr, r, lane); continue; } r -= I_OUT;
        if (r < I_UP) { transpose_item(a.in[17] + (size_t)l * D * FF2, D, FF2, (bf16*)(ws + WS_WUP) + (size_t)l * FF2 * D, scr, r, lane); continue; } r -= I_UP;
        transpose_item(a.in[20] + (size_t)l * FF * D, FF, D, (bf16*)(ws + WS_WDN) + (size_t)l * D * FF, scr, r, lane);
    }
    const int gt = blockIdx.x * 512 + tid, NT_ = G * 512;
    { bf16* Gt = (bf16*)(ws + WS_GT);
      for (int idx = gt; idx < DEPTH * 16 * 2 * 64 * 64; idx += NT_) { const int i = idx & 63, j = (idx >> 6) & 63, mat = (idx >> 12) & 1, lg = idx >> 13;
          const float v = (mat ? a.in[6] : a.in[4])[((size_t)lg * 64 + i) * 64 + j]; Gt[idx] = (bf16)(cvtpk(v, 0.f) & 0xffffu); } }
    { const f32x4* xs = (const f32x4*)a.in[0]; v2u* xo = (v2u*)(ws + WS_XBF);
      for (int idx = gt; idx < T * D / 4; idx += NT_) { const f32x4 v = xs[idx]; v2u o; o.x = cvtpk(v.x, v.y); o.y = cvtpk(v.z, v.w); xo[idx] = o; } }
}

__device__ __forceinline__ void fold_phase(const Args& a, int G, const int tid_in) {
    const int lane = tid_in & 63, wave = __builtin_amdgcn_readfirstlane(tid_in >> 6);
    const int gw = blockIdx.x * 8 + wave, NGW = G * 8;
    constexpr int NROWS = 3 * INW + 4 * FF2;
    const int per = (NROWS + NGW - 1) / NGW; int r = gw * per; const int rend = (r + per < NROWS) ? r + per : NROWS;
    float* cd = (float*)(a.ws + WS_CD);
    while (r < rend) {
        int l, base, nrow, isup;
        if (r < 3 * INW) { l = 1 + r / INW; base = (l - 1) * INW; nrow = INW; isup = 0; } else { l = (r - 3 * INW) / FF2; base = 3 * INW + l * FF2; nrow = FF2; isup = 1; }
        const int e = (base + nrow < rend) ? base + nrow : rend;
        const bf16* Wt = isup ? (const bf16*)(a.ws + WS_WUP) + (size_t)l * FF2 * D : (const bf16*)(a.ws + WS_WIN) + (size_t)l * INW * D;
        const float* g = isup ? a.in[15] + (size_t)l * D : a.in[21] + (size_t)(l - 1) * D; const float* b = isup ? a.in[16] + (size_t)l * D : a.in[22] + (size_t)(l - 1) * D;
        float* c = cd + (size_t)l * 32768 + (isup ? 10240 : 0); float* d = cd + (size_t)l * 32768 + (isup ? 21504 : 5120);
        fold_rows(Wt, g, b, c, d, r - base, e - base, lane);
        r = e;
    }
}

__device__ __forceinline__ void ln_phase(const float* __restrict__ Y, const float* __restrict__ g, const float* __restrict__ b, float* __restrict__ outF, int G, const int tid_in) {
    const int tid = tid_in, lane = tid & 63, wave = tid >> 6;
    const int gw = blockIdx.x * 8 + wave, NGW = G * 8;
    for (int m = gw; m < T; m += NGW) {
        const f32x4* yr = (const f32x4*)(Y + (size_t)m * D) + lane;
        f32x4 v[8]; float s = 0.f;
#pragma unroll
        for (int j = 0; j < 8; ++j) { v[j] = yr[64 * j]; s += (v[j].x + v[j].y) + (v[j].z + v[j].w); }
        const float mean = wave_sum(s) * (1.f / D); float s2 = 0.f;
#pragma unroll
        for (int j = 0; j < 8; ++j) { v[j] = v[j] - mean; s2 += (v[j].x * v[j].x + v[j].y * v[j].y) + (v[j].z * v[j].z + v[j].w * v[j].w); }
        const float rstd = 1.f / sqrtf(wave_sum(s2) * (1.f / D) + 1e-5f);
        f32x4* of = (f32x4*)(outF + (size_t)m * D) + lane;
#pragma unroll
        for (int j = 0; j < 8; ++j) { const f32x4 gg = ((const f32x4*)g)[lane + 64 * j], bb = ((const f32x4*)b)[lane + 64 * j];
            const f32x4 o = v[j] * rstd * gg + bb; of[64 * j] = o; }
    }
}

__device__ __forceinline__ void convgelu_phase(const bf16* __restrict__ Z, const float* __restrict__ cw, const float* __restrict__ cb, bf16* __restrict__ H, int G, const int tid_in) {
    const int gid = blockIdx.x * 512 + tid_in, NTH = G * 512;
    constexpr int CG_ROWS = 16;
    for (int it = gid; it < (T / CG_ROWS) * (FF / 8); it += NTH) {
        const int fc = it % (FF / 8), rb = it / (FF / 8), f = fc * 8, t0 = rb * CG_ROWS;
        float wg[3][8], wu[3][8], bg[8], bu[8];
#pragma unroll
        for (int k = 0; k < 3; ++k) { const f32x4 a0 = *(const f32x4*)(cw + k * FF2 + f), a1 = *(const f32x4*)(cw + k * FF2 + f + 4), c0 = *(const f32x4*)(cw + k * FF2 + FF + f), c1 = *(const f32x4*)(cw + k * FF2 + FF + f + 4);
#pragma unroll
            for (int e = 0; e < 4; ++e) { wg[k][e] = a0[e]; wg[k][4 + e] = a1[e]; wu[k][e] = c0[e]; wu[k][4 + e] = c1[e]; } }
        { const f32x4 a0 = *(const f32x4*)(cb + f), a1 = *(const f32x4*)(cb + f + 4), c0 = *(const f32x4*)(cb + FF + f), c1 = *(const f32x4*)(cb + FF + f + 4);
#pragma unroll
          for (int e = 0; e < 4; ++e) { bg[e] = a0[e]; bg[4 + e] = a1[e]; bu[e] = c0[e]; bu[4 + e] = c1[e]; } }
        v4u g2 = {0, 0, 0, 0}, g1 = {0, 0, 0, 0}, u2 = {0, 0, 0, 0}, u1 = {0, 0, 0, 0};
        const bf16* zp = Z + (size_t)t0 * FF2 + f;
        if ((t0 & (SEQ - 1)) != 0) { g2 = *(const v4u*)(zp - 2 * (size_t)FF2); g1 = *(const v4u*)(zp - (size_t)FF2); u2 = *(const v4u*)(zp - 2 * (size_t)FF2 + FF); u1 = *(const v4u*)(zp - (size_t)FF2 + FF); }
        bf16* hp = H + (size_t)t0 * FF + f;
        for (int n4 = 0; n4 < CG_ROWS; n4 += 4) {
            v4u gq[4], uq[4];
#pragma unroll
            for (int i = 0; i < 4; ++i) { gq[i] = *(const v4u*)(zp + (size_t)(n4 + i) * FF2); uq[i] = *(const v4u*)(zp + (size_t)(n4 + i) * FF2 + FF); }
#pragma unroll
            for (int i = 0; i < 4; ++i) { const v4u g0 = gq[i], u0 = uq[i];
                float o[8];
#pragma unroll
                for (int e = 0; e < 4; ++e) {
                    const float ga = bg[2 * e] + wg[0][2 * e] * bflo(g2[e]) + wg[1][2 * e] * bflo(g1[e]) + wg[2][2 * e] * bflo(g0[e]);
                    const float gb = bg[2 * e + 1] + wg[0][2 * e + 1] * bfhi(g2[e]) + wg[1][2 * e + 1] * bfhi(g1[e]) + wg[2][2 * e + 1] * bfhi(g0[e]);
                    const float ua = bu[2 * e] + wu[0][2 * e] * bflo(u2[e]) + wu[1][2 * e] * bflo(u1[e]) + wu[2][2 * e] * bflo(u0[e]);
                    const float ub = bu[2 * e + 1] + wu[0][2 * e + 1] * bfhi(u2[e]) + wu[1][2 * e + 1] * bfhi(u1[e]) + wu[2][2 * e + 1] * bfhi(u0[e]);
                    o[2 * e] = gelu_tanh(ga) * ua; o[2 * e + 1] = gelu_tanh(gb) * ub;
                }
                v4u w; w.x = cvtpk(o[0], o[1]); w.y = cvtpk(o[2], o[3]); w.z = cvtpk(o[4], o[5]); w.w = cvtpk(o[6], o[7]);
                *(v4u*)(hp + (size_t)(n4 + i) * FF) = w;
                g2 = g1; g1 = g0; u2 = u1; u1 = u0; }
        }
    }
}

__device__ __forceinline__ void rg_item(LAS unsigned char* lds, int item, const bf16* __restrict__ proj, bf16* __restrict__ mix, const bf16* __restrict__ Gt,
                                        const float* __restrict__ conv_w, const float* __restrict__ conv_b, const float* __restrict__ ba, const float* __restrict__ bx,
                                        const float* __restrict__ lamp, unsigned* masks, unsigned long long* slots, const int tid_in) {
    const int tid = tid_in, lane = tid & 63, wid = __builtin_amdgcn_readfirstlane(tid >> 6);
    const int kblk = item >> 6, bg = item & 63, b = bg >> 4, g = bg & 15, t0 = kblk * 256;
    const size_t rowbase = (size_t)b * SEQ;
    LAS float* U = (LAS float*)lds;
    LAS unsigned char* RAW = lds + 69632;
    { const bf16* xg = proj + rowbase * INW + 64 * g; v4u rawv[5];
#pragma unroll
      for (int i5 = 0; i5 < 5; ++i5) { const int c = tid + 512 * i5, r = c >> 3, t = t0 - 3 + r; rawv[i5] = (v4u){0u, 0u, 0u, 0u};
          if (c < 259 * 8 && t >= 0) rawv[i5] = *(const v4u*)(xg + (size_t)t * INW + (c & 7) * 8); }
#pragma unroll
      for (int i5 = 0; i5 < 5; ++i5) { const int c = tid + 512 * i5; if (c < 259 * 8) *(LAS v4u*)(RAW + c * 16) = rawv[i5]; } }
    __syncthreads();
    { const int i = tid & 63, run = tid >> 6, ch = 64 * g + i;
      const float w0 = conv_w[ch], w1 = conv_w[1024 + ch], w2 = conv_w[2048 + ch], w3 = conv_w[3072 + ch], cbv = conv_b[ch];
      const LAS bf16* xr = (const LAS bf16*)RAW + (run * 32) * 64 + i;
      float x0 = bf2f(xr[0]), x1 = bf2f(xr[64]), x2 = bf2f(xr[128]);
#pragma unroll 8
      for (int n = 0; n < 32; ++n) { const float x3 = bf2f(xr[(n + 3) * 64]); U[(run * 32 + n) * 68 + i] = cbv + w0 * x0 + w1 * x1 + w2 * x2 + w3 * x3; x0 = x1; x1 = x2; x2 = x3; } }
    __syncthreads();
    const int cb = wid & 3, th = wid >> 2, seg = kblk * 2 + th;
    const int q = lane >> 4, c16 = lane & 15, j = 16 * cb + c16, ch = 64 * g + j;
    const bf16* gp = Gt + ((size_t)(g * 2) * 64 + j) * 64 + 8 * q;
    bf16x8 Ba[2], Bx[2];
#pragma unroll
    for (int s = 0; s < 2; ++s) { Ba[s] = *(const bf16x8*)(gp + 32 * s); Bx[s] = *(const bf16x8*)(gp + 4096 + 32 * s); }
    const float bav = ba[ch], bxv = bx[ch];
    const float c2 = -8.0f * log1pf(__expf(-lamp[ch])) * LOG2E;
    const bf16* gbase = proj + (rowbase + t0 + th * 128) * INW + 1024 + 64 * g;
    const unsigned goff = (unsigned)(4 * q) * INW + j;
    bf16 gtv[8][4];
#pragma unroll
    for (int mt = 0; mt < 8; ++mt)
#pragma unroll
        for (int r = 0; r < 4; ++r) gtv[mt][r] = (gbase + (size_t)(mt * 16 + r) * INW)[goff];
    asm volatile("" ::: "memory");
    float Hl[8][4], Pc[8][4]; float cP = 1.f, cH = 0.f;
#pragma unroll
    for (int mt = 0; mt < 8; ++mt) {
        const int rt = th * 128 + mt * 16;
        const LAS float* ur = U + (rt + c16) * 68 + 8 * q;
        const f32x4 a0 = *(const LAS f32x4*)(ur), a1 = *(const LAS f32x4*)(ur + 4), a2 = *(const LAS f32x4*)(ur + 32), a3 = *(const LAS f32x4*)(ur + 36);
        v4u A0u, A1u; A0u.x = cvtpk(a0.x, a0.y); A0u.y = cvtpk(a0.z, a0.w); A0u.z = cvtpk(a1.x, a1.y); A0u.w = cvtpk(a1.z, a1.w);
        A1u.x = cvtpk(a2.x, a2.y); A1u.y = cvtpk(a2.z, a2.w); A1u.z = cvtpk(a3.x, a3.y); A1u.w = cvtpk(a3.z, a3.w);
        const bf16x8 A0 = __builtin_bit_cast(bf16x8, A0u), A1 = __builtin_bit_cast(bf16x8, A1u);
        f32x4 accr = {0.f, 0.f, 0.f, 0.f}, acci = {0.f, 0.f, 0.f, 0.f};
        accr = __builtin_amdgcn_mfma_f32_16x16x32_bf16(A0, Ba[0], accr, 0, 0, 0); accr = __builtin_amdgcn_mfma_f32_16x16x32_bf16(A1, Ba[1], accr, 0, 0, 0);
        acci = __builtin_amdgcn_mfma_f32_16x16x32_bf16(A0, Bx[0], acci, 0, 0, 0); acci = __builtin_amdgcn_mfma_f32_16x16x32_bf16(A1, Bx[1], acci, 0, 0, 0);
        float av[4], bv[4];
#pragma unroll
        for (int r = 0; r < 4; ++r) {
            const float u = U[(rt + 4 * q + r) * 68 + j];
            const float rr = sigmoidf_(accr[r] + bav), ig = sigmoidf_(acci[r] + bxv);
            const float l2a = c2 * rr, a = ex2(l2a), x = 2.0f * 0.6931471805599453f * l2a;
            const float om = (x > -0.02f) ? -x * (1.0f + x * (0.5f + x * (1.0f / 6.0f))) : 1.0f - a * a;
            av[r] = a; bv[r] = sqrtf(om) * ig * u;
        }
        float A_ = av[0], H_ = bv[0]; Pc[mt][0] = A_; Hl[mt][0] = H_;
#pragma unroll
        for (int r = 1; r < 4; ++r) { H_ = av[r] * H_ + bv[r]; A_ *= av[r]; Pc[mt][r] = A_; Hl[mt][r] = H_; }
        float tA = A_, tH = H_;
        { const float pA = __shfl_up(tA, 16), pH = __shfl_up(tH, 16); if (q >= 1) { tH = tA * pH + tH; tA = tA * pA; } }
        { const float pA = __shfl_up(tA, 32), pH = __shfl_up(tH, 32); if (q >= 2) { tH = tA * pH + tH; tA = tA * pA; } }
        float eA = __shfl_up(tA, 16), eH = __shfl_up(tH, 16); if (q == 0) { eA = 1.f; eH = 0.f; }
        const float inA = cP * eA, inH = eA * cH + eH;
#pragma unroll
        for (int r = 0; r < 4; ++r) { Hl[mt][r] = Pc[mt][r] * inH + Hl[mt][r]; Pc[mt][r] = Pc[mt][r] * inA; }
        const float totA = __shfl(tA, 48 + c16), totH = __shfl(tH, 48 + c16);
        cH = totA * cH + totH; cP = cP * totA;
        asm volatile("" ::: "memory");
    }
    unsigned long long* sl = slots + ((size_t)b * 16) * 1024 + ch;
    if (q == 0) __hip_atomic_store(sl + (size_t)seg * 1024, ((unsigned long long)__float_as_uint(cH) << 32) | __float_as_uint(cP), __ATOMIC_RELAXED, __HIP_MEMORY_SCOPE_AGENT);
    asm volatile("s_waitcnt vmcnt(0)" ::: "memory");
    unsigned* mk = masks + bg * 4 + cb;
    if (lane == 0) __hip_atomic_fetch_or(mk, 1u << seg, __ATOMIC_RELAXED, __HIP_MEMORY_SCOPE_AGENT);
    const unsigned need = (1u << seg) - 1u;
    if (need) { unsigned sp = 0;
        while (((unsigned)__builtin_amdgcn_readfirstlane(__hip_atomic_load(mk, __ATOMIC_RELAXED, __HIP_MEMORY_SCOPE_AGENT)) & need) != need) { __builtin_amdgcn_s_sleep(2); if (++sp > (1u << 22)) break; }
        asm volatile("" ::: "memory"); }
    unsigned long long sw[15];
#pragma unroll
    for (int s2 = 0; s2 < 15; ++s2) { sw[s2] = 0ull; if (s2 < seg) sw[s2] = __hip_atomic_load(sl + (size_t)s2 * 1024, __ATOMIC_RELAXED, __HIP_MEMORY_SCOPE_AGENT); }
    float hin = 0.f;
#pragma unroll
    for (int s2 = 0; s2 < 15; ++s2) if (s2 < seg) hin = __uint_as_float((unsigned)(sw[s2] >> 32)) + __uint_as_float((unsigned)sw[s2]) * hin;
    bf16* obase = mix + (rowbase + t0 + th * 128) * D + 64 * g;
    const unsigned ooff = (unsigned)(4 * q) * D + j;
#pragma unroll
    for (int mt = 0; mt < 8; ++mt)
#pragma unroll
        for (int r = 0; r < 4; ++r) { const float hv = Hl[mt][r] + Pc[mt][r] * hin;
            const float o = hv * gelu_tanh(bf2f(gtv[mt][r])); (obase + (size_t)(mt * 16 + r) * D)[ooff] = (bf16)(cvtpk(o, 0.f) & 0xffffu); }
    __syncthreads();
}

__device__ __forceinline__ void attn_unit(LAS unsigned char* lds, const bf16* __restrict__ proj, bf16* __restrict__ mix, int b, int h, int qb, float lam, float sl2,
                                          const float* __restrict__ sg, float oscale, const int tid_in) {
    constexpr int KSTR = 144, VSTR = 320, KBY = 64 * KSTR, STG = 2 * KBY + 64 * VSTR;
    const int tid = tid_in, lane = tid & 63, wid = __builtin_amdgcn_readfirstlane(tid >> 6);
    const int comp = wid >> 2, rg = wid & 3, r32 = lane & 31, hi = lane >> 5;
    const int q0 = qb * 128 + rg * 32;
    const size_t rowbase = (size_t)b * SEQ;
    const bf16* qp = proj + (rowbase + q0 + r32) * INW + 2048 + h * 128 + comp * 64 + hi * 8;
    LAS unsigned char* qs = lds + 2 * STG + wid * 4608 + r32 * KSTR + hi * 16;
    const float c1 = 0.125f * LOG2E;
#pragma unroll
    for (int d0 = 0; d0 < 4; ++d0) { const v4u qv = *(const v4u*)(qp + d0 * 16); v4u qo;
#pragma unroll
        for (int e = 0; e < 4; ++e) qo[e] = cvtpk(bflo(qv[e]) * c1, bfhi(qv[e]) * c1);
        *(LAS v4u*)(qs + d0 * 32) = qo; }
    f32x16 o[4];
#pragma unroll
    for (int vb = 0; vb < 4; ++vb)
#pragma unroll
        for (int r = 0; r < 16; ++r) o[vb][r] = 0.f;
    float mref = 0.f, l = 0.f;
    const int NT = 2 * qb + 2;
    const int krow = tid >> 3, kch = tid & 7, vrow = tid >> 4, vch = tid & 15;
    const bf16* ksrc = proj + (rowbase + krow) * INW + 3072 + h * 128 + kch * 8;
    const bf16* vsrc = proj + (rowbase + vrow) * INW + 4096 + h * 128 + vch * 8;
    v4u rk1, rk2, rv0, rv1;
#define AT_LOAD(kt) do { const size_t o_ = (size_t)(kt) * 64 * INW; rk1 = *(const v4u*)(ksrc + o_); rk2 = *(const v4u*)(ksrc + o_ + 64); rv0 = *(const v4u*)(vsrc + o_); rv1 = *(const v4u*)(vsrc + o_ + (size_t)32 * INW); } while (0)
#define AT_STORE(buf) do { LAS unsigned char* s_ = lds + (buf) * STG; *(LAS v4u*)(s_ + krow * KSTR + kch * 16) = rk1; *(LAS v4u*)(s_ + KBY + krow * KSTR + kch * 16) = rk2; \
        *(LAS v4u*)(s_ + 2 * KBY + vrow * VSTR + vch * 16) = rv0; *(LAS v4u*)(s_ + 2 * KBY + (vrow + 32) * VSTR + vch * 16) = rv1; } while (0)
    AT_LOAD(0); AT_STORE(0); __syncthreads();
    const int qpos = q0 + r32;
    for (int kt = 0; kt < NT; ++kt) {
        const bool more = kt + 1 < NT;
        if (more) AT_LOAD(kt + 1);
        if (kt * 64 <= q0 + 31) {
            LAS const unsigned char* sb = lds + (kt & 1) * STG;
            LAS const unsigned char* kc = sb + comp * KBY + r32 * KSTR + hi * 16;
            f32x16 p0, p1;
            float base = sl2 * (float)(kt * 64 + 4 * hi - qpos) - mref; asm volatile("" : "+v"(base));
#pragma unroll
            for (int r = 0; r < 16; ++r) { p0[r] = __builtin_fmaf(sl2, (float)((r & 3) + 8 * (r >> 2)), base); p1[r] = __builtin_fmaf(sl2, (float)((r & 3) + 8 * (r >> 2) + 32), base); }
#pragma unroll
            for (int d0 = 0; d0 < 4; ++d0) { const bf16x8 k0 = *(LAS const bf16x8*)(kc + d0 * 32), k1 = *(LAS const bf16x8*)(kc + 32 * KSTR + d0 * 32), qv = *(LAS const bf16x8*)(qs + d0 * 32);
                p0 = __builtin_amdgcn_mfma_f32_32x32x16_bf16(k0, qv, p0, 0, 0, 0); p1 = __builtin_amdgcn_mfma_f32_32x32x16_bf16(k1, qv, p1, 0, 0, 0); }
            if (kt * 64 + 63 > q0) { const int dqi = qpos - kt * 64 - 4 * hi;
#pragma unroll
                for (int r = 0; r < 16; ++r) { if ((r & 3) + 8 * (r >> 2) > dqi) p0[r] = -INFINITY; if ((r & 3) + 8 * (r >> 2) + 32 > dqi) p1[r] = -INFINITY; } }
            float mx = __builtin_fmaxf(__builtin_fmaxf(p0[0], p1[0]), p0[1]);
#pragma unroll
            for (int r = 1; r < 16; ++r) mx = (r == 1) ? __builtin_fmaxf(mx, p1[1]) : __builtin_fmaxf(__builtin_fmaxf(mx, p0[r]), p1[r]);
            mx = fmaxf(mx, __shfl_xor(mx, 32));
            if (__any(mx > 8.0f)) { const float dl = fmaxf(mx, 0.f), f = ex2(-dl); mref += dl; l *= f;
#pragma unroll
                for (int r = 0; r < 16; ++r) { p0[r] -= dl; p1[r] -= dl; }
#pragma unroll
                for (int vb = 0; vb < 4; ++vb)
#pragma unroll
                    for (int r = 0; r < 16; ++r) o[vb][r] *= f; }
            float ps = 0.f;
#pragma unroll
            for (int r = 0; r < 16; ++r) { p0[r] = ex2(p0[r]); p1[r] = ex2(p1[r]); ps += p0[r] + p1[r]; }
            l += ps;
            v4u pw[4];
#pragma unroll
            for (int e = 0; e < 4; ++e) { pw[0][e] = cvtpk(p0[2 * e], p0[2 * e + 1]); pw[1][e] = cvtpk(p0[8 + 2 * e], p0[9 + 2 * e]); pw[2][e] = cvtpk(p1[2 * e], p1[2 * e + 1]); pw[3][e] = cvtpk(p1[8 + 2 * e], p1[9 + 2 * e]); }
            LAS const unsigned char* vbp = sb + 2 * KBY + (4 * hi + ((lane & 15) >> 2)) * VSTR + ((lane >> 4) & 1) * 32 + (lane & 3) * 8;
#pragma unroll
            for (int s = 0; s < 4; ++s) { const bf16x8 pf = __builtin_bit_cast(bf16x8, pw[s]);
#pragma unroll
                for (int vb = 0; vb < 4; ++vb) {
                    const s16x4 lo = __builtin_bit_cast(s16x4, __builtin_amdgcn_ds_read_tr16_b64_v4i16((LAS s16x4*)(vbp + (16 * s) * VSTR + vb * 64)));
                    const s16x4 hh = __builtin_bit_cast(s16x4, __builtin_amdgcn_ds_read_tr16_b64_v4i16((LAS s16x4*)(vbp + (16 * s + 8) * VSTR + vb * 64)));
                    const bf16x8 vf = (bf16x8){lo[0], lo[1], lo[2], lo[3], hh[0], hh[1], hh[2], hh[3]};
                    o[vb] = __builtin_amdgcn_mfma_f32_32x32x16_bf16(vf, pf, o[vb], 0, 0, 0); }
                asm volatile("" ::: "memory"); }
        }
        if (more) AT_STORE((kt + 1) & 1);
        __syncthreads();
    }
#undef AT_LOAD
#undef AT_STORE
    l += __shfl_xor(l, 32);
    const float inv = 1.0f / l;
    LAS float* X = (LAS float*)lds;
    if (comp == 1) { const float sc = inv * lam;
#pragma unroll
        for (int vb = 0; vb < 4; ++vb)
#pragma unroll
            for (int r = 0; r < 16; ++r) X[(rg * 64 + vb * 16 + r) * 64 + lane] = o[vb][r] * sc; }
    __syncthreads();
    if (comp == 0) {
        float ss = 0.f;
#pragma unroll
        for (int vb = 0; vb < 4; ++vb)
#pragma unroll
            for (int r = 0; r < 16; ++r) { const float v = o[vb][r] * inv - X[(rg * 64 + vb * 16 + r) * 64 + lane]; o[vb][r] = v; ss += v * v; if ((r & 3) == 3) asm volatile("" ::: "memory"); }
        ss += __shfl_xor(ss, 32);
        const float rs = oscale / sqrtf(ss * (1.0f / 128.0f) + 1e-5f);
        LAS unsigned char* stg = lds + 65536 + rg * 8704;
#pragma unroll
        for (int vb = 0; vb < 4; ++vb)
#pragma unroll
            for (int r4 = 0; r4 < 4; ++r4) { const int v0 = 32 * vb + 8 * r4 + 4 * hi; const f32x4 g4 = *(const f32x4*)(sg + v0);
                v2u w; w.x = cvtpk(o[vb][4 * r4] * rs * g4.x, o[vb][4 * r4 + 1] * rs * g4.y); w.y = cvtpk(o[vb][4 * r4 + 2] * rs * g4.z, o[vb][4 * r4 + 3] * rs * g4.w);
                *(LAS v2u*)(stg + r32 * 272 + v0 * 2) = w; asm volatile("" ::: "memory"); }
        asm volatile("s_waitcnt lgkmcnt(0)" ::: "memory");
#pragma unroll
        for (int i = 0; i < 8; ++i) { const int c = i * 64 + lane, row = c >> 4, chn = c & 15; const v4u v = *(LAS const v4u*)(stg + row * 272 + chn * 16);
            *(v4u*)(mix + (rowbase + q0 + row) * D + 1024 + h * 128 + chn * 8) = v; }
    }
    __syncthreads();
}

#define XB_TMO      128
#define XB_XCNT(j)  (256  + 64 * (j))
#define XB_XSUB(j)  (1280 + 64 * (j))
#define XB_XGEN(j)  (2304 + 64 * (j))
#define XB_TOP      3328
#define XB_TOPGEN   3392
#define XCD_BAR_WORDS 3456
#define XB_SPIN_CAP (1u << 18)

__device__ __forceinline__ unsigned xb_ld(unsigned* p)              { return __hip_atomic_load(p, __ATOMIC_RELAXED, __HIP_MEMORY_SCOPE_AGENT); }
__device__ __forceinline__ unsigned xb_add(unsigned* p, unsigned v) { return __hip_atomic_fetch_add(p, v, __ATOMIC_RELAXED, __HIP_MEMORY_SCOPE_AGENT); }
__device__ __forceinline__ unsigned xb_xcc_id() { return (unsigned)__builtin_amdgcn_s_getreg((3 << 11) | 20) & 0xFu; }
#define XB_SPIN(cond, bar) do { unsigned _sp = 0; while (cond) { __builtin_amdgcn_s_sleep(1); \
    if ((++_sp & 255u) == 0u) { if (xb_ld(&(bar)[XB_TMO])) break; if (_sp > XB_SPIN_CAP) { atomicAdd(&(bar)[XB_TMO], 1u); break; } } } } while (0)

struct XcdBarrier {
    unsigned* bar; unsigned x;
    volatile LAS unsigned* st;
};

__device__ __forceinline__ XcdBarrier xcd_barrier_post(unsigned* bar, volatile LAS unsigned* st) {
    XcdBarrier b; b.bar = bar; b.x = xb_xcc_id(); b.st = st;
    if (threadIdx.x == 0) (void)xb_add(&bar[XB_XCNT(b.x)], 1u);
    return b;
}
__device__ __forceinline__ void xcd_barrier_complete(unsigned* bar, unsigned x, unsigned& nloc, unsigned& nx) {
    const unsigned G = gridDim.x * gridDim.y * gridDim.z;
    unsigned sum, cnt, mine, sp = 0u;
    for (;;) {
        sum = 0u; cnt = 0u; mine = 0u;
#pragma unroll
        for (unsigned j = 0; j < 16; ++j) { const unsigned c = xb_ld(&bar[XB_XCNT(j)]); sum += c; cnt += (c > 0u) ? 1u : 0u; mine = (j == x) ? c : mine; }
        if (sum == G) break;
        __builtin_amdgcn_s_sleep(1);
        if ((++sp & 255u) == 0u) { if (xb_ld(&bar[XB_TMO])) break; if (sp > XB_SPIN_CAP) { atomicAdd(&bar[XB_TMO], 1u); break; } }
    }
    nloc = mine > 0u ? mine : 1u; nx = cnt > 0u ? cnt : 1u;
}

__device__ __forceinline__ void xcd_barrier(const XcdBarrier& b, const int tid) {
    asm volatile("s_waitcnt vmcnt(0)" ::: "memory");
    __syncthreads();
    if (tid == 0) {
        unsigned* bar = b.bar;
        __builtin_amdgcn_s_waitcnt(0);
        unsigned nloc = b.st[0], nx = b.st[1];
        if (nloc == 0u) { xcd_barrier_complete(bar, b.x, nloc, nx); b.st[0] = nloc; b.st[1] = nx; }
        const unsigned old = xb_add(&bar[XB_XSUB(b.x)], 1u);
        const unsigned gen = old / nloc;
        if (old + 1u == (gen + 1u) * nloc) {
            __builtin_amdgcn_fence(__ATOMIC_RELEASE, "agent");
            asm volatile("s_waitcnt vmcnt(0)" ::: "memory");
            const unsigned og = xb_add(&bar[XB_TOP], 1u);
            const unsigned tg = og / nx;
            if (og + 1u == (tg + 1u) * nx) xb_add(&bar[XB_TOPGEN], 1u);
            else XB_SPIN(xb_ld(&bar[XB_TOPGEN]) == tg, bar);
            __builtin_amdgcn_fence(__ATOMIC_ACQUIRE, "agent");
            xb_add(&bar[XB_XGEN(b.x)], 1u);
            asm volatile("s_waitcnt vmcnt(0)" ::: "memory");
        } else {
            XB_SPIN(xb_ld(&bar[XB_XGEN(b.x)]) == gen, bar);
            __builtin_amdgcn_fence(__ATOMIC_ACQUIRE, "agent");
            asm volatile("s_waitcnt vmcnt(0)" ::: "memory");
        }
    }
    __syncthreads();
}

__global__ void __launch_bounds__(512, 2) fwd_kernel(Args a) {
    extern __shared__ __attribute__((aligned(16))) unsigned char lds_raw[];
    LAS unsigned char* lds = (LAS unsigned char*)lds_raw;
    cg::grid_group grid = cg::this_grid();
    const int G = gridDim.x;
    const int wid0 = __builtin_amdgcn_readfirstlane((int)threadIdx.x >> 6);
    unsigned char* ws = a.ws;
    bf16* XBF = (bf16*)(ws + WS_XBF); bf16* PROJ = (bf16*)(ws + WS_PROJ); bf16* MIX = (bf16*)(ws + WS_MIX); bf16* Z = (bf16*)(ws + WS_Z); bf16* HB = (bf16*)(ws + WS_H);
    float* Y = (float*)(ws + WS_Y); float* S1 = (float*)(ws + WS_S1); float* S2 = (float*)(ws + WS_S2); const float* CD = (const float*)(ws + WS_CD);
    volatile LAS unsigned* MISC = (volatile LAS unsigned*)(lds + 146432);
    if (threadIdx.x < 32) MISC[threadIdx.x] = 0u;
    __syncthreads();
    const XcdBarrier xbar = xcd_barrier_post((unsigned*)(ws + WS_CTL) + 4096, MISC + 8);
    for (int ph = a.ph_lo; ph < a.ph_hi; ++ph) {
        if (a.ph_hi > 4096) grid.sync();
        if (ph > a.ph_lo) { int wq_ = wid0; unsigned ones_ = ~0u; asm volatile("" : "+s"(wq_), "+s"(ones_));
            xcd_barrier(xbar, wq_ * 64 + (int)__builtin_amdgcn_mbcnt_hi(ones_, __builtin_amdgcn_mbcnt_lo(ones_, 0u))); }
#ifdef REP_MASK
        const int kk_ = ph == 0 ? 8 : (ph == NPHASE - 1 ? 6 : ((ph - 1) % 6)); const int nrep = ((REP_MASK >> kk_) & 1) ? 2 : 1;
        for (int rep = 0; rep < nrep; ++rep) { if (rep) xcd_barrier(xbar, (int)threadIdx.x);
#endif
        int wq = wid0; unsigned ones = ~0u; asm volatile("" : "+s"(wq), "+s"(ones));
        int tid = wq * 64 + (int)__builtin_amdgcn_mbcnt_hi(ones, __builtin_amdgcn_mbcnt_lo(ones, 0u)); asm volatile("" : "+v"(tid));
        const int l = (ph - 1) / 6, k = (ph - 1) % 6;
        if (ph == 0) {
#ifndef NO_PRO
            prologue(a, lds, G, tid);
#endif
        } else if (ph == NPHASE - 1) {
#ifndef NO_LN
            ln_phase(Y, a.in[21] + (size_t)(DEPTH - 1) * D, a.in[22] + (size_t)(DEPTH - 1) * D, a.out, G, tid);
#endif
        } else if (k == 0 || k == 3) {
            const int N = (k == 0) ? INW : FF2;
            const bf16* Bt = (k == 0) ? (const bf16*)(ws + WS_WIN) + (size_t)l * INW * D : (const bf16*)(ws + WS_WUP) + (size_t)l * FF2 * D;
            pg8::Gemm g{XBF, Bt, T, N, D}; pg8::StaticOrder S; S.init(T, N, G, (int)blockIdx.x);
            pg8::EpiBf16Ln E{(k == 0) ? PROJ : Z, N, (k == 0) ? S2 : S1, CD + (size_t)l * 32768 + (k == 0 ? 0 : 10240), CD + (size_t)l * 32768 + (k == 0 ? 5120 : 21504), lds + 131072, (k == 0 && l == 0) ? 0 : 1};
            if ((tid & 63) == 0) *((LAS int*)(lds + 131072 + 14336) + (tid >> 6)) = -1;
#ifndef NO_GEMM1
            pg8::gemm_phase<pg8::EpiBf16Ln, pg8::StaticOrder, true, true>(lds, g, S, E, tid);
#endif
        } else if (k == 2 || k == 5) {
            const int K = (k == 2) ? D : FF;
            const bf16* A = (k == 2) ? MIX : HB;
            const bf16* Bt = (k == 2) ? (const bf16*)(ws + WS_WOUT) + (size_t)l * D * D : (const bf16*)(ws + WS_WDN) + (size_t)l * D * FF;
            const bool ln = !(k == 2 && l == 0);
            const int lg = (k == 2) ? l - 1 : l;
            const float* gg = ((k == 2) ? a.in[21] : a.in[15]) + (size_t)(ln ? lg : 0) * D; const float* bb = ((k == 2) ? a.in[22] : a.in[16]) + (size_t)(ln ? lg : 0) * D;
            pg8::Gemm g{A, Bt, T, D, K}; pg8::StaticOrder S; S.init(T, D, G, (int)blockIdx.x);
            const float* gn = (k == 2) ? a.in[15] + (size_t)l * D : a.in[21] + (size_t)l * D;
#ifdef REP_MASK
            const bool dmy = (nrep == 2 && rep == 0);
            pg8::EpiResLn E{ln ? (const float*)Y : a.in[0], dmy ? (float*)(ws + 420 * MiB) : Y, dmy ? (bf16*)(ws + 388 * MiB) : XBF, D, DN_ALPHA, (k == 2) ? S2 : S1, gg, bb, gn, dmy ? (float*)(ws + 484 * MiB) : ((k == 2) ? S1 : S2), lds + 131072, ln ? 1 : 0};
#else
            pg8::EpiResLn E{ln ? (const float*)Y : a.in[0], Y, XBF, D, DN_ALPHA, (k == 2) ? S2 : S1, gg, bb, gn, (k == 2) ? S1 : S2, lds + 131072, ln ? 1 : 0};
#endif
#ifndef NO_GEMM2
            pg8::gemm_phase<pg8::EpiResLn, pg8::StaticOrder, true, true>(lds, g, S, E, tid);
#endif
        } else if (k == 4) {
#ifndef NO_CONV
            convgelu_phase(Z, a.in[18] + (size_t)l * 3 * FF2, a.in[19] + (size_t)l * FF2, HB, G, tid);
#endif
        } else {
            const int lane = tid & 63;
            const float d1 = wave_sum(a.in[9][l * 64 + lane] * a.in[10][l * 64 + lane]), d2 = wave_sum(a.in[11][l * 64 + lane] * a.in[12][l * 64 + lane]);
            const float lam_init = 0.8f - 0.6f * __expf(-0.3f * (float)l);
            const float lam = __expf(d1) - __expf(d2) + lam_init;
            unsigned* masks = (unsigned*)(ws + WS_CTL) + 1024 + l * 256;
            if (l == 0) fold_phase(a, G, tid);
#ifndef NO_RG
            for (int item = blockIdx.x; item < 512; item += G)
                rg_item(lds, item, PROJ, MIX, (const bf16*)(ws + WS_GT) + (size_t)l * 16 * 2 * 4096, a.in[2] + (size_t)l * 4096, a.in[3] + (size_t)l * 1024,
                        a.in[5] + (size_t)l * 1024, a.in[7] + (size_t)l * 1024, a.in[8] + (size_t)l * 1024, masks, (unsigned long long*)(ws + WS_SUM), tid);
#endif
#ifndef NO_ATTN
            for (int p = blockIdx.x; p < 256; p += G) { const int bh = p >> 3, s = p & 7, b = bh >> 3, h = bh & 7;
                const float sl2 = ex2(-(float)(h + 1)) * LOG2E;
                attn_unit(lds, PROJ, MIX, b, h, 15 - s, lam, sl2, a.in[13] + (size_t)l * 128, 1.0f - lam_init, tid);
                attn_unit(lds, PROJ, MIX, b, h, s, lam, sl2, a.in[13] + (size_t)l * 128, 1.0f - lam_init, tid); }
#endif
        }
#ifdef REP_MASK
        }
#endif
    }
#ifdef REP_SYNC
    for (int i = 0; i < REP_SYNC; ++i) xcd_barrier(xbar, (int)threadIdx.x);
#endif
}

extern "C" void kernel_launch(void* const* d_in, const int* in_sizes, int n_in, void* d_out, int out_size, void* d_ws, size_t ws_size, hipStream_t stream) {
    static int grid = 0;
    if (grid == 0) {
        if (n_in != 23 || in_sizes[0] != T * D || out_size != T * D || ws_size < WS_END) { fprintf(stderr, "kernel_launch: unexpected shapes (n_in %d, in0 %d, out %d, ws %zu)\n", n_in, n_in > 0 ? in_sizes[0] : -1, out_size, ws_size); grid = -1; return; }
        int dev = 0, cus = 0, per_cu = 0;
        hipGetDevice(&dev); hipDeviceGetAttribute(&cus, hipDeviceAttributeMultiprocessorCount, dev);
        if (hipFuncSetAttribute((const void*)fwd_kernel, hipFuncAttributeMaxDynamicSharedMemorySize, LDS_BYTES) != hipSuccess) { fprintf(stderr, "kernel_launch: hipFuncSetAttribute failed\n"); grid = -1; return; }
        if (hipOccupancyMaxActiveBlocksPerMultiprocessor(&per_cu, (const void*)fwd_kernel, 512, LDS_BYTES) != hipSuccess || per_cu < 1) { fprintf(stderr, "kernel_launch: occupancy query failed (%d)\n", per_cu); per_cu = 1; }
        (void)hipGetLastError();
        grid = cus * per_cu;
        fprintf(stderr, "kernel_launch: grid %d (cus %d x %d)\n", grid, cus, per_cu);
    }
    if (grid < 0) return;
    hipMemsetAsync((char*)d_ws + WS_CTL, 0, CTL_BYTES, stream);
    Args a{};
    for (int i = 0; i < 23; ++i) a.in[i] = (const float*)d_in[i];
    a.out = (float*)d_out; a.ws = (unsigned char*)d_ws;
#ifndef MK_SPLIT
    a.ph_lo = 0; a.ph_hi = NPHASE;
    void* args[] = {&a};
    hipError_t e = hipLaunchCooperativeKernel((const void*)fwd_kernel, dim3(grid), dim3(512), args, LDS_BYTES, stream);
    if (e != hipSuccess) fprintf(stderr, "cooperative launch failed: %s (grid %d)\n", hipGetErrorString(e), grid);
#else
    for (int ph = 0; ph < NPHASE; ++ph) { a.ph_lo = ph; a.ph_hi = ph + 1; void* args[] = {&a};
        hipError_t e = hipLaunchCooperativeKernel((const void*)fwd_kernel, dim3(grid), dim3(512), args, LDS_BYTES, stream);
        if (e != hipSuccess) { fprintf(stderr, "cooperative launch %d failed: %s (grid %d)\n", ph, hipGetErrorString(e), grid); break; } }
#endif
}
```

```cpp
#include <hip/hip_runtime.h>
#include <hip/hip_cooperative_groups.h>
#include <cstdio>
#include <cstdint>
namespace pg8 {
#define PG8_LAS __attribute__((address_space(3)))
typedef unsigned short bf16_t;
typedef short bf16x8 __attribute__((ext_vector_type(8)));
typedef float f32x4 __attribute__((ext_vector_type(4)));
typedef unsigned u32x4 __attribute__((ext_vector_type(4)));
constexpr int BM = 256, BK = 64, HALF = 128, HTB = HALF * BK * 2  , STAGE_BYTES = 8 * HTB, NXCD = 8, WGM = 8;

__host__ __device__ __forceinline__ int lds_byte(int r, int c) { const int st = (r >> 4) * 2 + (c >> 5), rr = r & 15, cc = c & 31, ob = rr * 64 + cc * 2; return st * 1024 + (ob ^ (((ob >> 9) & 1) << 5)); }
__host__ __device__ __forceinline__ void stage_rc(int b, int& R, int& C) { const int st = b / 1024, sb = b % 1024, swz = sb ^ (((sb >> 9) & 1) << 5); R = (st >> 1) * 16 + swz / 64; C = (st & 1) * 32 + (swz % 64) / 2; }
__host__ __device__ __forceinline__ int perm32(int rho) { const int n = rho >> 4, i = rho & 15; return 8 * (i >> 2) + 4 * n + (i & 3); }

struct Unit { int pm, pn; };
struct Gemm { const bf16_t* A; const bf16_t* Bt; int M, N, K; };

struct StaticOrder {
    int nM, nN, nwg, G, c;
    __host__ __device__ void init(int M, int N, int G_, int c_) { nM = M / BM; nN = N / BM; nwg = nM * nN; G = G_; c = c_; }
    __host__ __device__ bool next(int i, Unit& u) const {
        const long L = (long)i * G + c; if (L >= nwg) return false;
        int wgid = (int)L; { const int q = nwg / NXCD, r = nwg % NXCD, xcd = wgid % NXCD, off = wgid / NXCD; wgid = (xcd < r ? xcd * (q + 1) : r * (q + 1) + (xcd - r) * q) + off; }
        const int nig = WGM * nN, gid = wgid / nig, fm = gid * WGM, gsz = (nM - fm) < WGM ? (nM - fm) : WGM;
        u.pm = fm + ((wgid % nig) % gsz); u.pn = (wgid % nig) / gsz; return true;
    }
    __device__ __forceinline__ void a_ready(const Unit&) const {}
    __device__ __forceinline__ void done(const Unit&) const {}
};

typedef float cvt_f32x2_t __attribute__((ext_vector_type(2))); typedef __bf16 cvt_bf16x2_t __attribute__((ext_vector_type(2)));
__device__ __forceinline__ unsigned cvt_pk_bf16(float lo, float hi) { cvt_f32x2_t v = {lo, hi}; cvt_bf16x2_t b = __builtin_convertvector(v, cvt_bf16x2_t); return __builtin_bit_cast(unsigned, b); }
typedef float f32x2 __attribute__((ext_vector_type(2)));
__device__ __forceinline__ f32x2 gelu_pk(f32x2 v) {
    const f32x2 av = __builtin_elementwise_abs(v), d = av * 0.2316418882f + 1.0f;
    f32x2 t; t.x = __builtin_amdgcn_rcpf(d.x); t.y = __builtin_amdgcn_rcpf(d.y);
    f32x2 q = t * 0.5307027145f + (-0.7265760135f); q = q * t + 0.7107068705f; q = q * t + (-0.142248368f); q = q * t + 0.127414796f; q = q * t;
    const f32x2 s = (v * v) * (-0.72134752044f);
    f32x2 e; e.x = __builtin_amdgcn_exp2f(s.x); e.y = __builtin_amdgcn_exp2f(s.y);
    const f32x2 m = v * (q * e), r = v - m;
    f32x2 o; o.x = v.x < 0.f ? m.x : r.x; o.y = v.y < 0.f ? m.y : r.y; return o;
}

template <int ACT  > struct EpiBf16 {
    static constexpr bool PERM = true, AFTER_DRAIN = false; static_assert(ACT == 0 || ACT == 1, "EpiBf16: ACT is 0 (none) or 1 (gelu_pk)");
    bf16_t* O; int ldc; const float* bias; int split_cols; size_t split_stride; float scale0;
    __device__ __forceinline__ void operator()(const f32x4 (&acc)[2][2][4][2], const Unit& u, int wr, int wc, int fr, int fq) const {
        const int row0 = u.pm * BM + wr * 64 + fr; int colt = u.pn * BM; bf16_t* base = O;
        float sc = 1.f; if (split_cols) { const int t = colt / split_cols; base += (size_t)t * split_stride; colt -= t * split_cols; if (t == 0) sc = scale0; }
        const int col0 = colt + wc * 32 + 8 * fq, bcol0 = u.pn * BM + wc * 32 + 8 * fq;
        f32x4 bv[2][2];
#pragma unroll
        for (int bj = 0; bj < 2; ++bj)
#pragma unroll
            for (int n = 0; n < 2; ++n) bv[bj][n] = bias ? *(const f32x4*)(bias + bcol0 + bj * HALF + 4 * n) : (f32x4){0.f, 0.f, 0.f, 0.f};
#pragma unroll
        for (int ai = 0; ai < 2; ++ai)
#pragma unroll
            for (int m = 0; m < 4; ++m) { bf16_t* rowp = base + (size_t)(row0 + ai * HALF + m * 16) * ldc + col0;
#pragma unroll
                for (int bj = 0; bj < 2; ++bj) { f32x4 v0 = acc[ai][bj][m][0] + bv[bj][0], v1 = acc[ai][bj][m][1] + bv[bj][1];
                    if (ACT == 1) { f32x2 a = gelu_pk((f32x2){v0[0], v0[1]}), b = gelu_pk((f32x2){v0[2], v0[3]}), c = gelu_pk((f32x2){v1[0], v1[1]}), d = gelu_pk((f32x2){v1[2], v1[3]});
                        v0 = (f32x4){a.x, a.y, b.x, b.y}; v1 = (f32x4){c.x, c.y, d.x, d.y}; }
                    v0 = v0 * sc; v1 = v1 * sc; u32x4 w; w.x = cvt_pk_bf16(v0[0], v0[1]); w.y = cvt_pk_bf16(v0[2], v0[3]); w.z = cvt_pk_bf16(v1[0], v1[1]); w.w = cvt_pk_bf16(v1[2], v1[3]);
                    *(u32x4*)(rowp + bj * HALF) = w; } }
    }
};
constexpr int SSTR = 8192 + 32;
__device__ __forceinline__ void row_stats_table(const float* S, int pm, int wr, int lane, PG8_LAS float* tab) {
    const int half = lane >> 5, rl = (lane & 31) * 2;
    const f32x4* sp = (const f32x4*)((const f32x2*)S + (size_t)(pm * BM + half * HALF + wr * 64 + rl));
    float s0 = 0.f, q0 = 0.f, s1 = 0.f, q1 = 0.f;
#pragma unroll
    for (int b = 0; b < 4; ++b) { f32x4 v[8];
#pragma unroll
        for (int i = 0; i < 8; ++i) v[i] = sp[(size_t)(b * 8 + i) * (SSTR / 2)];
        asm volatile("" : "+v"(v[0]), "+v"(v[1]), "+v"(v[2]), "+v"(v[3]), "+v"(v[4]), "+v"(v[5]), "+v"(v[6]), "+v"(v[7]));
#pragma unroll
        for (int i = 0; i < 8; ++i) { s0 += v[i][0]; q0 += v[i][1]; s1 += v[i][2]; q1 += v[i][3]; } }
    const float m0 = s0 * (1.0f / 2048.0f), m1 = s1 * (1.0f / 2048.0f);
    f32x4 t; t[0] = m0; t[1] = 1.0f / sqrtf(q0 * (1.0f / 2048.0f) - m0 * m0 + 1e-5f); t[2] = m1; t[3] = 1.0f / sqrtf(q1 * (1.0f / 2048.0f) - m1 * m1 + 1e-5f);
    *(PG8_LAS f32x4*)(tab + (half * 64 + rl) * 2) = t;
    asm volatile("s_waitcnt lgkmcnt(0)" ::: "memory");
}
struct EpiBf16Ln {
    static constexpr bool PERM = true, AFTER_DRAIN = false;
    bf16_t* O; int ldc; const float* S; const float* cvec; const float* dvec; PG8_LAS unsigned char* ltab; int ln;
    __device__ __forceinline__ void operator()(const f32x4 (&acc)[2][2][4][2], const Unit& u, int wr, int wc, int fr, int fq) const {
        const int row0 = u.pm * BM + wr * 64 + fr, col0 = u.pn * BM + wc * 32 + 8 * fq;
        PG8_LAS float* tab = (PG8_LAS float*)(ltab + (wr * 4 + wc) * 1024);
        f32x4 cv[2][2], dv[2][2];
        if (ln) { PG8_LAS int* tag = (PG8_LAS int*)(ltab + 14336) + (wr * 4 + wc);
            if (__builtin_amdgcn_readfirstlane(*tag) != u.pm) { row_stats_table(S, u.pm, wr, fq * 16 + fr, tab); *tag = u.pm; }
#pragma unroll
            for (int bj = 0; bj < 2; ++bj)
#pragma unroll
                for (int n = 0; n < 2; ++n) { cv[bj][n] = *(const f32x4*)(cvec + col0 + bj * HALF + 4 * n); dv[bj][n] = *(const f32x4*)(dvec + col0 + bj * HALF + 4 * n); } }
#pragma unroll
        for (int ai = 0; ai < 2; ++ai)
#pragma unroll
            for (int m = 0; m < 4; ++m) { bf16_t* rowp = O + (size_t)(row0 + ai * HALF + m * 16) * ldc + col0;
                float rs = 1.f, t = 0.f; if (ln) { const float mu = tab[(ai * 64 + m * 16 + fr) * 2]; rs = tab[(ai * 64 + m * 16 + fr) * 2 + 1]; t = -rs * mu; }
#pragma unroll
                for (int bj = 0; bj < 2; ++bj) { f32x4 v0 = acc[ai][bj][m][0], v1 = acc[ai][bj][m][1];
                    if (ln) { v0 = v0 * rs + (cv[bj][0] * t + dv[bj][0]); v1 = v1 * rs + (cv[bj][1] * t + dv[bj][1]); }
                    u32x4 w; w.x = cvt_pk_bf16(v0[0], v0[1]); w.y = cvt_pk_bf16(v0[2], v0[3]); w.z = cvt_pk_bf16(v1[0], v1[1]); w.w = cvt_pk_bf16(v1[2], v1[3]);
                    *(u32x4*)(rowp + bj * HALF) = w; } }
    }
};
struct EpiResLn {
    static constexpr bool PERM = false, AFTER_DRAIN = false;
    const float* base; float* Y; bf16_t* YB; int ldc; float alpha; const float* Sin; const float* g; const float* b; const float* gn; float* So; PG8_LAS unsigned char* ltab; int ln;
    __device__ __forceinline__ void operator()(const f32x4 (&acc)[2][2][4][2], const Unit& u, int wr, int wc, int fr, int fq) const {
        const int row0 = u.pm * BM + wr * 64 + fr, col0 = u.pn * BM + wc * 32 + 4 * fq;
        PG8_LAS float* tab = (PG8_LAS float*)(ltab + (wr * 4 + wc) * 1024);
        PG8_LAS float* cvl = (PG8_LAS float*)(ltab + 8192 + (wr * 4 + wc) * 768);
        { const int lane = fq * 16 + fr, gc = u.pn * BM + (lane >> 5) * HALF + wc * 32 + (lane & 31); cvl[lane] = g[gc]; cvl[64 + lane] = b[gc]; cvl[128 + lane] = gn[gc]; }
        if (ln) row_stats_table(Sin, u.pm, wr, fq * 16 + fr, tab);
        f32x4 xb[3][2][2];
#pragma unroll
        for (int pr = 0; pr < 2; ++pr)
#pragma unroll
            for (int bj = 0; bj < 2; ++bj)
#pragma unroll
                for (int n = 0; n < 2; ++n) xb[pr][bj][n] = *(const f32x4*)(base + (size_t)(row0 + pr * 16) * ldc + col0 + bj * HALF + n * 16);
#pragma unroll
        for (int ai = 0; ai < 2; ++ai)
#pragma unroll
            for (int m = 0; m < 4; ++m) { const int ri = ai * 4 + m, row = row0 + ai * HALF + m * 16; const size_t off = (size_t)row * ldc + col0;
                if (ri < 6) { const int nrow = row0 + ((ri + 2) >> 2) * HALF + ((ri + 2) & 3) * 16;
#pragma unroll
                    for (int bj = 0; bj < 2; ++bj)
#pragma unroll
                        for (int n = 0; n < 2; ++n) xb[(ri + 2) % 3][bj][n] = *(const f32x4*)(base + (size_t)nrow * ldc + col0 + bj * HALF + n * 16); }
                float mu = 0.f, rs = 1.f; if (ln) { mu = tab[(ai * 64 + m * 16 + fr) * 2]; rs = tab[(ai * 64 + m * 16 + fr) * 2 + 1]; }
                float s = 0.f, q = 0.f;
#pragma unroll
                for (int bj = 0; bj < 2; ++bj)
#pragma unroll
                    for (int n = 0; n < 2; ++n) { f32x4 x = xb[ri % 3][bj][n]; const int ci = bj * 32 + n * 16 + 4 * fq;
                        if (ln) x = (x - mu) * rs * *(const PG8_LAS f32x4*)(cvl + ci) + *(const PG8_LAS f32x4*)(cvl + 64 + ci);
                        const f32x4 o = x * alpha + acc[ai][bj][m][n];
                        *(f32x4*)(Y + off + bj * HALF + n * 16) = o;
                        const f32x4 og = o * *(const PG8_LAS f32x4*)(cvl + 128 + ci);
                        unsigned w0 = cvt_pk_bf16(og[0], og[1]), w1 = cvt_pk_bf16(og[2], og[3]);
                        *(unsigned long long*)(YB + off + bj * HALF + n * 16) = ((unsigned long long)w1 << 32) | w0;
                        s += (o[0] + o[1]) + (o[2] + o[3]); q += (o[0] * o[0] + o[1] * o[1]) + (o[2] * o[2] + o[3] * o[3]); }
                s += __shfl_xor(s, 16); s += __shfl_xor(s, 32); q += __shfl_xor(q, 16); q += __shfl_xor(q, 32);
                if (fq == 0) { f32x2 sq; sq[0] = s; sq[1] = q; ((f32x2*)So)[(size_t)(u.pn * 4 + wc) * SSTR + row] = sq; } }
    }
};
template <class Epi, class Sched, bool ALIGN_EPI = false, bool SP2 = false>
__device__ __forceinline__ void gemm_phase(PG8_LAS unsigned char* lds, const Gemm g, const Sched& S, const Epi& E, const int tid_in) {
    const int tid = tid_in, wid = __builtin_amdgcn_readfirstlane(tid >> 6), lane = tid & 63, wr = wid >> 2, wc = wid & 3, fr = lane & 15, fq = lane >> 4;
    const int K = g.K, nt = K / BK;
    unsigned voffA[2], voffB[2];
#pragma unroll
    for (int i = 0; i < 2; ++i) { int R, C; stage_rc(tid * 16 + i * 8192, R, C); const int Rb = Epi::PERM ? ((R & ~31) + perm32(R & 31)) : R;
        voffA[i] = (unsigned)(R * K + C) * 2u; voffB[i] = (unsigned)(Rb * K + C) * 2u; }
    const size_t kstep = (size_t)(BK * 2);
    const size_t hstep = (size_t)HALF * K * 2;
    const size_t tstep = 2 * hstep;
    const unsigned ldsw = (unsigned)wid * 1024u;
    const int aoff = lds_byte(wr * 64 + fr, fq * 8), boff = lds_byte(wc * 32 + fr, fq * 8);
#define PG8_SA(b, h) (((b) * 2 + (h)) * HTB)
#define PG8_SB(b, h) ((4 + (b) * 2 + (h)) * HTB)
#define PG8_STAGE(bufoff, gbase, voff) do { _Pragma("unroll") for (int _i = 0; _i < 2; ++_i) \
        __builtin_amdgcn_global_load_lds((const unsigned*)((const char*)(gbase) + (voff)[_i]), (PG8_LAS unsigned*)(lds + (bufoff) + ldsw + _i * 8192), 16, 0, 0); } while (0)
#define PG8_LDA(dst, b, h) do { _Pragma("unroll") for (int m = 0; m < 4; ++m) _Pragma("unroll") for (int k = 0; k < 2; ++k) dst[m][k] = *(const PG8_LAS bf16x8*)(lds + PG8_SA(b, h) + aoff + m * 2048 + k * 1024); } while (0)
#define PG8_LDB(dst, b, h) do { _Pragma("unroll") for (int n = 0; n < 2; ++n) _Pragma("unroll") for (int k = 0; k < 2; ++k) dst[n][k] = *(const PG8_LAS bf16x8*)(lds + PG8_SB(b, h) + boff + n * 2048 + k * 1024); } while (0)
#define PG8_MMA(ai, bj, At, Bt) do { __builtin_amdgcn_s_setprio(1); _Pragma("unroll") for (int m = 0; m < 4; ++m) _Pragma("unroll") for (int n = 0; n < 2; ++n) _Pragma("unroll") for (int k = 0; k < 2; ++k) \
        acc[ai][bj][m][n] = __builtin_amdgcn_mfma_f32_16x16x32_bf16(Bt[n][k], At[m][k], acc[ai][bj][m][n], 0, 0, 0); __builtin_amdgcn_s_setprio(0); } while (0)
#define PG8_WAIT_V(n) asm volatile("s_waitcnt vmcnt(" #n ")" ::: "memory")
#define PG8_WAIT_L(n) asm volatile("s_waitcnt lgkmcnt(" #n ")" ::: "memory")
#define PG8_BAR __builtin_amdgcn_s_barrier()
#define PG8_SCHED __builtin_amdgcn_sched_barrier(0)
    Unit cur, nxt; int ui = 0;
    if (!S.next(0, cur)) return;
    f32x4 acc[2][2][4][2];
#pragma unroll
    for (int a = 0; a < 2; ++a)
#pragma unroll
        for (int b = 0; b < 2; ++b)
#pragma unroll
            for (int m = 0; m < 4; ++m)
#pragma unroll
                for (int n = 0; n < 2; ++n) acc[a][b][m][n] = (f32x4){0.f, 0.f, 0.f, 0.f};
    bf16x8 At[4][2], B0[2][2], B1[2][2];
    const char* cA = (const char*)g.A + (size_t)cur.pm * tstep; const char* cB = (const char*)g.Bt + (size_t)cur.pn * tstep;
    S.a_ready(cur);
    if constexpr (SP2) {
        PG8_STAGE(PG8_SB(0, 0), cB, voffB); PG8_STAGE(PG8_SB(0, 1), cB + hstep, voffB); PG8_STAGE(PG8_SA(0, 0), cA, voffA); PG8_STAGE(PG8_SA(0, 1), cA + hstep, voffA);
        if (wr == 1) PG8_BAR;
        PG8_WAIT_V(2); PG8_BAR;
        PG8_STAGE(PG8_SB(1, 0), cB + kstep, voffB); PG8_STAGE(PG8_SA(1, 0), cA + kstep, voffA); PG8_STAGE(PG8_SB(1, 1), cB + hstep + kstep, voffB);
        PG8_WAIT_V(6); PG8_BAR;
    } else {
        PG8_STAGE(PG8_SB(0, 0), cB, voffB); PG8_STAGE(PG8_SA(0, 0), cA, voffA); PG8_STAGE(PG8_SB(0, 1), cB + hstep, voffB); PG8_STAGE(PG8_SA(0, 1), cA + hstep, voffA);
        if (wr == 1) PG8_BAR;
        PG8_WAIT_V(4); PG8_BAR;
        PG8_STAGE(PG8_SB(1, 0), cB + kstep, voffB); PG8_STAGE(PG8_SA(1, 0), cA + kstep, voffA); PG8_STAGE(PG8_SB(1, 1), cB + hstep + kstep, voffB);
        PG8_WAIT_V(6); PG8_BAR;
    }
    for (;;) {
        const bool has_next = S.next(ui + 1, nxt);
        const char* nA = has_next ? (const char*)g.A + (size_t)nxt.pm * tstep : cA; const char* nB = has_next ? (const char*)g.Bt + (size_t)nxt.pn * tstep : cB;
        for (int t = 0; t < nt; t += 2) {
            const bool last = (t == nt - 2);
            const char* a1 = cA + (size_t)(t + 1) * kstep;
            const char* a2 = last ? nA : cA + (size_t)(t + 2) * kstep; const char* b2 = last ? nB : cB + (size_t)(t + 2) * kstep;
            const char* a3 = a2 + kstep; const char* b3 = b2 + kstep;
            if (last && has_next) S.a_ready(nxt);
            if constexpr (SP2) {
            PG8_LDB(B0, 0, 0); PG8_LDB(B1, 0, 1); PG8_SCHED; PG8_LDA(At, 0, 0); PG8_STAGE(PG8_SA(1, 1), a1 + hstep, voffA);
            PG8_WAIT_V(8); PG8_WAIT_L(0); PG8_BAR; PG8_MMA(0, 0, At, B0); PG8_MMA(0, 1, At, B1); PG8_BAR; PG8_SCHED;
            PG8_LDA(At, 0, 1); PG8_STAGE(PG8_SB(0, 0), b2, voffB); PG8_STAGE(PG8_SB(0, 1), b2 + hstep, voffB); PG8_STAGE(PG8_SA(0, 0), a2, voffA);
            PG8_WAIT_V(8); PG8_WAIT_L(0); PG8_BAR; PG8_MMA(1, 0, At, B0); PG8_MMA(1, 1, At, B1); PG8_BAR; PG8_SCHED;
            PG8_LDB(B0, 1, 0); PG8_LDB(B1, 1, 1); PG8_SCHED; PG8_LDA(At, 1, 0); PG8_STAGE(PG8_SA(0, 1), a2 + hstep, voffA);
            PG8_WAIT_V(8); PG8_WAIT_L(0); PG8_BAR; PG8_MMA(0, 0, At, B0); PG8_MMA(0, 1, At, B1); PG8_BAR; PG8_SCHED;
            PG8_LDA(At, 1, 1); PG8_STAGE(PG8_SB(1, 0), b3, voffB); PG8_STAGE(PG8_SB(1, 1), b3 + hstep, voffB); PG8_STAGE(PG8_SA(1, 0), a3, voffA);
            PG8_WAIT_V(8); PG8_WAIT_L(0); PG8_BAR; PG8_MMA(1, 0, At, B0); PG8_MMA(1, 1, At, B1); PG8_BAR; PG8_SCHED;
            } else {
            PG8_LDB(B0, 0, 0); PG8_SCHED; PG8_LDA(At, 0, 0); PG8_STAGE(PG8_SA(1, 1), a1 + hstep, voffA);
            PG8_WAIT_L(8); PG8_BAR; PG8_WAIT_L(0); PG8_MMA(0, 0, At, B0); PG8_BAR; PG8_SCHED;
            PG8_LDB(B1, 0, 1); PG8_STAGE(PG8_SB(0, 0), b2, voffB);
            PG8_BAR; PG8_WAIT_L(0); PG8_MMA(0, 1, At, B1); PG8_BAR;
            PG8_LDA(At, 0, 1); PG8_STAGE(PG8_SA(0, 0), a2, voffA);
            PG8_BAR; PG8_WAIT_L(0); PG8_MMA(1, 0, At, B0); PG8_BAR; PG8_SCHED;
            PG8_STAGE(PG8_SB(0, 1), b2 + hstep, voffB);
            PG8_WAIT_V(6); PG8_BAR; PG8_MMA(1, 1, At, B1); PG8_BAR;
            PG8_LDB(B0, 1, 0); PG8_SCHED; PG8_LDA(At, 1, 0); PG8_STAGE(PG8_SA(0, 1), a2 + hstep, voffA);
            PG8_WAIT_L(8); PG8_BAR; PG8_WAIT_L(0); PG8_MMA(0, 0, At, B0); PG8_BAR; PG8_SCHED;
            PG8_LDB(B1, 1, 1); PG8_STAGE(PG8_SB(1, 0), b3, voffB);
            PG8_BAR; PG8_WAIT_L(0); PG8_MMA(0, 1, At, B1); PG8_BAR;
            PG8_LDA(At, 1, 1); PG8_STAGE(PG8_SA(1, 0), a3, voffA);
            PG8_BAR; PG8_WAIT_L(0); PG8_MMA(1, 0, At, B0); PG8_BAR; PG8_SCHED;
            PG8_STAGE(PG8_SB(1, 1), b3 + hstep, voffB);
            PG8_WAIT_V(6); PG8_BAR; PG8_MMA(1, 1, At, B1); PG8_BAR;
            }
        }
        if constexpr (ALIGN_EPI) { if (wr == 0) PG8_BAR; }
        if constexpr (!Epi::AFTER_DRAIN) { E(acc, cur, wr, wc, fr, fq); S.done(cur); }
        if (!has_next) break;
#pragma unroll
        for (int a = 0; a < 2; ++a)
#pragma unroll
            for (int b = 0; b < 2; ++b)
#pragma unroll
                for (int m = 0; m < 4; ++m)
#pragma unroll
                    for (int n = 0; n < 2; ++n) acc[a][b][m][n] = (f32x4){0.f, 0.f, 0.f, 0.f};
        cur = nxt; cA = nA; cB = nB; ++ui;
        if constexpr (ALIGN_EPI) { if (wr == 1) PG8_BAR; }
    }
    PG8_WAIT_V(0);
    if constexpr (!ALIGN_EPI) { if (wr == 0) PG8_BAR; }
    PG8_BAR;
    if constexpr (Epi::AFTER_DRAIN) { E.fused(acc, cur, wr, wc, fr, fq, lds, wid, lane); S.done(cur); }
#undef PG8_SA
#undef PG8_SB
#undef PG8_STAGE
#undef PG8_LDA
#undef PG8_LDB
#undef PG8_MMA
#undef PG8_WAIT_V
#undef PG8_WAIT_L
#undef PG8_BAR
#undef PG8_SCHED
}
}
namespace cg = cooperative_groups;
#define LAS __attribute__((address_space(3)))
typedef unsigned short bf16;
typedef unsigned v4u __attribute__((ext_vector_type(4)));
typedef unsigned v2u __attribute__((ext_vector_type(2)));
typedef float f32x4 __attribute__((ext_vector_type(4)));
typedef float f32x16 __attribute__((ext_vector_type(16)));
typedef short bf16x8 __attribute__((ext_vector_type(8)));
typedef short s16x4 __attribute__((ext_vector_type(4)));

constexpr int T = 8192, SEQ = 2048, D = 2048, INW = 5120, FF = 5632, FF2 = 11264, DEPTH = 4;
constexpr int NPHASE = 2 + 6 * DEPTH;
constexpr float LOG2E = 1.4426950408889634f;
constexpr float DN_ALPHA = 1.681792830507429f;
constexpr size_t MiB = 1u << 20;
constexpr size_t WS_CTL = 0, CTL_BYTES = 1 * MiB, WS_SUM = 1 * MiB, WS_GT = 2 * MiB, WS_WIN = 4 * MiB, WS_WOUT = 84 * MiB, WS_WUP = 116 * MiB, WS_WDN = 292 * MiB,
                 WS_S1 = 404 * MiB, WS_S2 = 408 * MiB, WS_CD = 384 * MiB, WS_PCD = 386 * MiB, WS_Y = 508 * MiB, WS_XBF = 572 * MiB, WS_PROJ = 604 * MiB, WS_MIX = 684 * MiB, WS_Z = 716 * MiB, WS_H = 892 * MiB, WS_END = 980 * MiB;
constexpr int LDS_BYTES = 147456;

__device__ __forceinline__ unsigned cvtpk(float lo, float hi) { return pg8::cvt_pk_bf16(lo, hi); }
__device__ __forceinline__ float bf2f(bf16 v) { return __uint_as_float((unsigned)v << 16); }
__device__ __forceinline__ float bflo(unsigned w) { return __uint_as_float(w << 16); }
__device__ __forceinline__ float bfhi(unsigned w) { return __uint_as_float(w & 0xffff0000u); }
__device__ __forceinline__ float ex2(float x) { return __builtin_amdgcn_exp2f(x); }
__device__ __forceinline__ float rcp(float x) { return __builtin_amdgcn_rcpf(x); }
__device__ __forceinline__ float sigmoidf_(float x) { return rcp(1.0f + ex2(-LOG2E * x)); }
__device__ __forceinline__ float gelu_tanh(float x) { const float y = x * (1.0f + 0.044715f * x * x); return x * rcp(1.0f + ex2(-2.0f * 0.7978845608028654f * LOG2E * y)); }
__device__ __forceinline__ float wave_sum(float v) {
#pragma unroll
    for (int o = 1; o < 64; o <<= 1) v += __shfl_xor(v, o);
    return v;
}

__device__ __forceinline__ void transpose_item(const float* __restrict__ W, int K, int N, bf16* __restrict__ WT, LAS float* scr, int item, int lane) {
    const int nblk = N / 32, kb = item / nblk, nb = item % nblk, k0 = 64 * kb, n0 = 32 * nb;
    const float* Wb = W + (size_t)k0 * N + n0; const unsigned loff = (unsigned)(lane >> 5) * (unsigned)N + (unsigned)(lane & 31);
#pragma unroll 8
    for (int i = 0; i < 32; ++i) { const int kk = 2 * i + (lane >> 5); scr[kk * 33 + (lane & 31)] = (Wb + (size_t)(2 * i) * N)[loff]; }
    asm volatile("s_waitcnt lgkmcnt(0)" ::: "memory");
    const int c = lane & 7;
#pragma unroll
    for (int j = 0; j < 4; ++j) { const int n = (lane >> 3) + 8 * j; const LAS float* s = scr + (8 * c) * 33 + n;
        v4u o; o.x = cvtpk(s[0 * 33], s[1 * 33]); o.y = cvtpk(s[2 * 33], s[3 * 33]); o.z = cvtpk(s[4 * 33], s[5 * 33]); o.w = cvtpk(s[6 * 33], s[7 * 33]);
        *(v4u*)(WT + (size_t)(n0 + n) * K + k0 + 8 * c) = o; }
    asm volatile("s_waitcnt lgkmcnt(0)" ::: "memory");
}

__device__ __forceinline__ void fold_rows(const bf16* __restrict__ Wt, const float* __restrict__ g, const float* __restrict__ b, float* __restrict__ c, float* __restrict__ d, int r0, int r1, int lane) {
    float gr[4][8], br[4][8];
#pragma unroll
    for (int j = 0; j < 4; ++j) { const f32x4 g0 = *(const f32x4*)(g + 512 * j + 8 * lane), g1 = *(const f32x4*)(g + 512 * j + 8 * lane + 4), b0 = *(const f32x4*)(b + 512 * j + 8 * lane), b1 = *(const f32x4*)(b + 512 * j + 8 * lane + 4);
#pragma unroll
        for (int e = 0; e < 4; ++e) { gr[j][e] = g0[e]; gr[j][4 + e] = g1[e]; br[j][e] = b0[e]; br[j][4 + e] = b1[e]; } }
    for (int r = r0; r < r1; ++r) { const v4u* wp = (const v4u*)(Wt + (size_t)r * D) + lane; v4u w[4];
#pragma unroll
        for (int j = 0; j < 4; ++j) w[j] = wp[64 * j];
        float cs = 0.f, ds = 0.f;
#pragma unroll
        for (int j = 0; j < 4; ++j)
#pragma unroll
            for (int e = 0; e < 4; ++e) { const float lo = bflo(w[j][e]), hi = bfhi(w[j][e]); cs += gr[j][2 * e] * lo + gr[j][2 * e + 1] * hi; ds += br[j][2 * e] * lo + br[j][2 * e + 1] * hi; }
        cs = wave_sum(cs); ds = wave_sum(ds);
        if (lane == 0) { c[r] = cs; d[r] = ds; } }
}
struct Args { const float* in[23]; float* out; unsigned char* ws; int ph_lo, ph_hi; };

__device__ __forceinline__ void prologue(const Args& a, LAS unsigned char* lds, int G, const int tid_in) {
    const int tid = tid_in, lane = tid & 63, wave = __builtin_amdgcn_readfirstlane(tid >> 6);
    LAS float* scr = (LAS float*)(lds + wave * 16384);
    const int gw = blockIdx.x * 8 + wave, NGW = G * 8;
    unsigned char* ws = a.ws;
    constexpr int I_IN = 32 * 160, I_OUT = 32 * 64, I_UP = 32 * 352, I_DN = 88 * 64, I_L = I_IN + I_OUT + I_UP + I_DN;
    for (int it = gw; it < DEPTH * I_L; it += NGW) {
        const int l = it / I_L; int r = it % I_L;
        if (r < I_IN) { transpose_item(a.in[1] + (size_t)l * D * INW, D, INW, (bf16*)(ws + WS_WIN) + (size_t)l * INW * D, scr, r, lane); continue; } r -= I_IN;
        if (r < I_OUT) { transpose_item(a.in[14] + (size_t)l * D * D, D, D, (bf16*)(ws + WS_WOUT) + (size_t)l * D * D, scr, r, lane); continue; } r -= I_OUT;
        if (r < I_UP) { transpose_item(a.in[17] + (size_t)l * D * FF2, D, FF2, (bf16*)(ws + WS_WUP) + (size_t)l * FF2 * D, scr, r, lane); continue; } r -= I_UP;
        transpose_item(a.in[20] + (size_t)l * FF * D, FF, D, (bf16*)(ws + WS_WDN) + (size_t)l * D * FF, scr, r, lane);
    }
    const int gt = blockIdx.x * 512 + tid, NT_ = G * 512;
    { bf16* Gt = (bf16*)(ws + WS_GT);
      for (int idx = gt; idx < DEPTH * 16 * 2 * 64 * 64; idx += NT_) { const int i = idx & 63, j = (idx >> 6) & 63, mat = (idx >> 12) & 1, lg = idx >> 13;
          const float v = (mat ? a.in[6] : a.in[4])[((size_t)lg * 64 + i) * 64 + j]; Gt[idx] = (bf16)(cvtpk(v, 0.f) & 0xffffu); } }
    { const f32x4* xs = (const f32x4*)a.in[0]; v2u* xo = (v2u*)(ws + WS_XBF);
      for (int idx = gt; idx < T * D / 4; idx += NT_) { const f32x4 v = xs[idx]; v2u o; o.x = cvtpk(v.x, v.y); o.y = cvtpk(v.z, v.w); xo[idx] = o; } }
}

__device__ __forceinline__ void fold_phase(const Args& a, int G, const int tid_in) {
    const int lane = tid_in & 63, wave = __builtin_amdgcn_readfirstlane(tid_in >> 6);
    const int gw = blockIdx.x * 8 + wave, NGW = G * 8;
    constexpr int NROWS = 3 * INW + 4 * FF2;
    const int per = (NROWS + NGW - 1) / NGW; int r = gw * per; const int rend = (r + per < NROWS) ? r + per : NROWS;
    float* cd = (float*)(a.ws + WS_CD);
    while (r < rend) {
        int l, base, nrow, isup;
        if (r < 3 * INW) { l = 1 + r / INW; base = (l - 1) * INW; nrow = INW; isup = 0; } else { l = (r - 3 * INW) / FF2; base = 3 * INW + l * FF2; nrow = FF2; isup = 1; }
        const int e = (base + nrow < rend) ? base + nrow : rend;
        const bf16* Wt = isup ? (const bf16*)(a.ws + WS_WUP) + (size_t)l * FF2 * D : (const bf16*)(a.ws + WS_WIN) + (size_t)l * INW * D;
        const float* g = isup ? a.in[15] + (size_t)l * D : a.in[21] + (size_t)(l - 1) * D; const float* b = isup ? a.in[16] + (size_t)l * D : a.in[22] + (size_t)(l - 1) * D;
        float* c = cd + (size_t)l * 32768 + (isup ? 10240 : 0); float* d = cd + (size_t)l * 32768 + (isup ? 21504 : 5120);
        fold_rows(Wt, g, b, c, d, r - base, e - base, lane);
        r = e;
    }
}

__device__ __forceinline__ void ln_phase(const float* __restrict__ Y, const float* __restrict__ g, const float* __restrict__ b, float* __restrict__ outF, int G, const int tid_in) {
    const int tid = tid_in, lane = tid & 63, wave = tid >> 6;
    const int gw = blockIdx.x * 8 + wave, NGW = G * 8;
    for (int m = gw; m < T; m += NGW) {
        const f32x4* yr = (const f32x4*)(Y + (size_t)m * D) + lane;
        f32x4 v[8]; float s = 0.f;
#pragma unroll
        for (int j = 0; j < 8; ++j) { v[j] = yr[64 * j]; s += (v[j].x + v[j].y) + (v[j].z + v[j].w); }
        const float mean = wave_sum(s) * (1.f / D); float s2 = 0.f;
#pragma unroll
        for (int j = 0; j < 8; ++j) { v[j] = v[j] - mean; s2 += (v[j].x * v[j].x + v[j].y * v[j].y) + (v[j].z * v[j].z + v[j].w * v[j].w); }
        const float rstd = 1.f / sqrtf(wave_sum(s2) * (1.f / D) + 1e-5f);
        f32x4* of = (f32x4*)(outF + (size_t)m * D) + lane;
#pragma unroll
        for (int j = 0; j < 8; ++j) { const f32x4 gg = ((const f32x4*)g)[lane + 64 * j], bb = ((const f32x4*)b)[lane + 64 * j];
            const f32x4 o = v[j] * rstd * gg + bb; of[64 * j] = o; }
    }
}

__device__ __forceinline__ void convgelu_phase(const bf16* __restrict__ Z, const float* __restrict__ cw, const float* __restrict__ cb, bf16* __restrict__ H, int G, const int tid_in) {
    const int gid = blockIdx.x * 512 + tid_in, NTH = G * 512;
    constexpr int CG_ROWS = 16;
    for (int it = gid; it < (T / CG_ROWS) * (FF / 8); it += NTH) {
        const int fc = it % (FF / 8), rb = it / (FF / 8), f = fc * 8, t0 = rb * CG_ROWS;
        float wg[3][8], wu[3][8], bg[8], bu[8];
#pragma unroll
        for (int k = 0; k < 3; ++k) { const f32x4 a0 = *(const f32x4*)(cw + k * FF2 + f), a1 = *(const f32x4*)(cw + k * FF2 + f + 4), c0 = *(const f32x4*)(cw + k * FF2 + FF + f), c1 = *(const f32x4*)(cw + k * FF2 + FF + f + 4);
#pragma unroll
            for (int e = 0; e < 4; ++e) { wg[k][e] = a0[e]; wg[k][4 + e] = a1[e]; wu[k][e] = c0[e]; wu[k][4 + e] = c1[e]; } }
        { const f32x4 a0 = *(const f32x4*)(cb + f), a1 = *(const f32x4*)(cb + f + 4), c0 = *(const f32x4*)(cb + FF + f), c1 = *(const f32x4*)(cb + FF + f + 4);
#pragma unroll
          for (int e = 0; e < 4; ++e) { bg[e] = a0[e]; bg[4 + e] = a1[e]; bu[e] = c0[e]; bu[4 + e] = c1[e]; } }
        v4u g2 = {0, 0, 0, 0}, g1 = {0, 0, 0, 0}, u2 = {0, 0, 0, 0}, u1 = {0, 0, 0, 0};
        const bf16* zp = Z + (size_t)t0 * FF2 + f;
        if ((t0 & (SEQ - 1)) != 0) { g2 = *(const v4u*)(zp - 2 * (size_t)FF2); g1 = *(const v4u*)(zp - (size_t)FF2); u2 = *(const v4u*)(zp - 2 * (size_t)FF2 + FF); u1 = *(const v4u*)(zp - (size_t)FF2 + FF); }
        bf16* hp = H + (size_t)t0 * FF + f;
        for (int n4 = 0; n4 < CG_ROWS; n4 += 4) {
            v4u gq[4], uq[4];
#pragma unroll
            for (int i = 0; i < 4; ++i) { gq[i] = *(const v4u*)(zp + (size_t)(n4 + i) * FF2); uq[i] = *(const v4u*)(zp + (size_t)(n4 + i) * FF2 + FF); }
#pragma unroll
            for (int i = 0; i < 4; ++i) { const v4u g0 = gq[i], u0 = uq[i];
                float o[8];
#pragma unroll
                for (int e = 0; e < 4; ++e) {
                    const float ga = bg[2 * e] + wg[0][2 * e] * bflo(g2[e]) + wg[1][2 * e] * bflo(g1[e]) + wg[2][2 * e] * bflo(g0[e]);
                    const float gb = bg[2 * e + 1] + wg[0][2 * e + 1] * bfhi(g2[e]) + wg[1][2 * e + 1] * bfhi(g1[e]) + wg[2][2 * e + 1] * bfhi(g0[e]);
                    const float ua = bu[2 * e] + wu[0][2 * e] * bflo(u2[e]) + wu[1][2 * e] * bflo(u1[e]) + wu[2][2 * e] * bflo(u0[e]);
                    const float ub = bu[2 * e + 1] + wu[0][2 * e + 1] * bfhi(u2[e]) + wu[1][2 * e + 1] * bfhi(u1[e]) + wu[2][2 * e + 1] * bfhi(u0[e]);
                    o[2 * e] = gelu_tanh(ga) * ua; o[2 * e + 1] = gelu_tanh(gb) * ub;
                }
                v4u w; w.x = cvtpk(o[0], o[1]); w.y = cvtpk(o[2], o[3]); w.z = cvtpk(o[4], o[5]); w.w = cvtpk(o[6], o[7]);
                *(v4u*)(hp + (size_t)(n4 + i) * FF) = w;
                g2 = g1; g1 = g0; u2 = u1; u1 = u0; }
        }
    }
}

__device__ __forceinline__ void rg_item(LAS unsigned char* lds, int item, const bf16* __restrict__ proj, bf16* __restrict__ mix, const bf16* __restrict__ Gt,
                                        const float* __restrict__ conv_w, const float* __restrict__ conv_b, const float* __restrict__ ba, const float* __restrict__ bx,
                                        const float* __restrict__ lamp, unsigned* masks, unsigned long long* slots, const int tid_in) {
    const int tid = tid_in, lane = tid & 63, wid = __builtin_amdgcn_readfirstlane(tid >> 6);
    const int kblk = item >> 6, bg = item & 63, b = bg >> 4, g = bg & 15, t0 = kblk * 256;
    const size_t rowbase = (size_t)b * SEQ;
    LAS float* U = (LAS float*)lds;
    LAS unsigned char* RAW = lds + 69632;
    { const bf16* xg = proj + rowbase * INW + 64 * g; v4u rawv[5];
#pragma unroll
      for (int i5 = 0; i5 < 5; ++i5) { const int c = tid + 512 * i5, r = c >> 3, t = t0 - 3 + r; rawv[i5] = (v4u){0u, 0u, 0u, 0u};
          if (c < 259 * 8 && t >= 0) rawv[i5] = *(const v4u*)(xg + (size_t)t * INW + (c & 7) * 8); }
#pragma unroll
      for (int i5 = 0; i5 < 5; ++i5) { const int c = tid + 512 * i5; if (c < 259 * 8) *(LAS v4u*)(RAW + c * 16) = rawv[i5]; } }
    __syncthreads();
    { const int i = tid & 63, run = tid >> 6, ch = 64 * g + i;
      const float w0 = conv_w[ch], w1 = conv_w[1024 + ch], w2 = conv_w[2048 + ch], w3 = conv_w[3072 + ch], cbv = conv_b[ch];
      const LAS bf16* xr = (const LAS bf16*)RAW + (run * 32) * 64 + i;
      float x0 = bf2f(xr[0]), x1 = bf2f(xr[64]), x2 = bf2f(xr[128]);
#pragma unroll 8
      for (int n = 0; n < 32; ++n) { const float x3 = bf2f(xr[(n + 3) * 64]); U[(run * 32 + n) * 68 + i] = cbv + w0 * x0 + w1 * x1 + w2 * x2 + w3 * x3; x0 = x1; x1 = x2; x2 = x3; } }
    __syncthreads();
    const int cb = wid & 3, th = wid >> 2, seg = kblk * 2 + th;
    const int q = lane >> 4, c16 = lane & 15, j = 16 * cb + c16, ch = 64 * g + j;
    const bf16* gp = Gt + ((size_t)(g * 2) * 64 + j) * 64 + 8 * q;
    bf16x8 Ba[2], Bx[2];
#pragma unroll
    for (int s = 0; s < 2; ++s) { Ba[s] = *(const bf16x8*)(gp + 32 * s); Bx[s] = *(const bf16x8*)(gp + 4096 + 32 * s); }
    const float bav = ba[ch], bxv = bx[ch];
    const float c2 = -8.0f * log1pf(__expf(-lamp[ch])) * LOG2E;
    const bf16* gbase = proj + (rowbase + t0 + th * 128) * INW + 1024 + 64 * g;
    const unsigned goff = (unsigned)(4 * q) * INW + j;
    bf16 gtv[8][4];
#pragma unroll
    for (int mt = 0; mt < 8; ++mt)
#pragma unroll
        for (int r = 0; r < 4; ++r) gtv[mt][r] = (gbase + (size_t)(mt * 16 + r) * INW)[goff];
    asm volatile("" ::: "memory");
    float Hl[8][4], Pc[8][4]; float cP = 1.f, cH = 0.f;
#pragma unroll
    for (int mt = 0; mt < 8; ++mt) {
        const int rt = th * 128 + mt * 16;
        const LAS float* ur = U + (rt + c16) * 68 + 8 * q;
        const f32x4 a0 = *(const LAS f32x4*)(ur), a1 = *(const LAS f32x4*)(ur + 4), a2 = *(const LAS f32x4*)(ur + 32), a3 = *(const LAS f32x4*)(ur + 36);
        v4u A0u, A1u; A0u.x = cvtpk(a0.x, a0.y); A0u.y = cvtpk(a0.z, a0.w); A0u.z = cvtpk(a1.x, a1.y); A0u.w = cvtpk(a1.z, a1.w);
        A1u.x = cvtpk(a2.x, a2.y); A1u.y = cvtpk(a2.z, a2.w); A1u.z = cvtpk(a3.x, a3.y); A1u.w = cvtpk(a3.z, a3.w);
        const bf16x8 A0 = __builtin_bit_cast(bf16x8, A0u), A1 = __builtin_bit_cast(bf16x8, A1u);
        f32x4 accr = {0.f, 0.f, 0.f, 0.f}, acci = {0.f, 0.f, 0.f, 0.f};
        accr = __builtin_amdgcn_mfma_f32_16x16x32_bf16(A0, Ba[0], accr, 0, 0, 0); accr = __builtin_amdgcn_mfma_f32_16x16x32_bf16(A1, Ba[1], accr, 0, 0, 0);
        acci = __builtin_amdgcn_mfma_f32_16x16x32_bf16(A0, Bx[0], acci, 0, 0, 0); acci = __builtin_amdgcn_mfma_f32_16x16x32_bf16(A1, Bx[1], acci, 0, 0, 0);
        float av[4], bv[4];
#pragma unroll
        for (int r = 0; r < 4; ++r) {
            const float u = U[(rt + 4 * q + r) * 68 + j];
            const float rr = sigmoidf_(accr[r] + bav), ig = sigmoidf_(acci[r] + bxv);
            const float l2a = c2 * rr, a = ex2(l2a), x = 2.0f * 0.6931471805599453f * l2a;
            const float om = (x > -0.02f) ? -x * (1.0f + x * (0.5f + x * (1.0f / 6.0f))) : 1.0f - a * a;
            av[r] = a; bv[r] = sqrtf(om) * ig * u;
        }
        float A_ = av[0], H_ = bv[0]; Pc[mt][0] = A_; Hl[mt][0] = H_;
#pragma unroll
        for (int r = 1; r < 4; ++r) { H_ = av[r] * H_ + bv[r]; A_ *= av[r]; Pc[mt][r] = A_; Hl[mt][r] = H_; }
        float tA = A_, tH = H_;
        { const float pA = __shfl_up(tA, 16), pH = __shfl_up(tH, 16); if (q >= 1) { tH = tA * pH + tH; tA = tA * pA; } }
        { const float pA = __shfl_up(tA, 32), pH = __shfl_up(tH, 32); if (q >= 2) { tH = tA * pH + tH; tA = tA * pA; } }
        float eA = __shfl_up(tA, 16), eH = __shfl_up(tH, 16); if (q == 0) { eA = 1.f; eH = 0.f; }
        const float inA = cP * eA, inH = eA * cH + eH;
#pragma unroll
        for (int r = 0; r < 4; ++r) { Hl[mt][r] = Pc[mt][r] * inH + Hl[mt][r]; Pc[mt][r] = Pc[mt][r] * inA; }
        const float totA = __shfl(tA, 48 + c16), totH = __shfl(tH, 48 + c16);
        cH = totA * cH + totH; cP = cP * totA;
        asm volatile("" ::: "memory");
    }
    unsigned long long* sl = slots + ((size_t)b * 16) * 1024 + ch;
    if (q == 0) __hip_atomic_store(sl + (size_t)seg * 1024, ((unsigned long long)__float_as_uint(cH) << 32) | __float_as_uint(cP), __ATOMIC_RELAXED, __HIP_MEMORY_SCOPE_AGENT);
    asm volatile("s_waitcnt vmcnt(0)" ::: "memory");
    unsigned* mk = masks + bg * 4 + cb;
    if (lane == 0) __hip_atomic_fetch_or(mk, 1u << seg, __ATOMIC_RELAXED, __HIP_MEMORY_SCOPE_AGENT);
    const unsigned need = (1u << seg) - 1u;
    if (need) { unsigned sp = 0;
        while (((unsigned)__builtin_amdgcn_readfirstlane(__hip_atomic_load(mk, __ATOMIC_RELAXED, __HIP_MEMORY_SCOPE_AGENT)) & need) != need) { __builtin_amdgcn_s_sleep(2); if (++sp > (1u << 22)) break; }
        asm volatile("" ::: "memory"); }
    unsigned long long sw[15];
#pragma unroll
    for (int s2 = 0; s2 < 15; ++s2) { sw[s2] = 0ull; if (s2 < seg) sw[s2] = __hip_atomic_load(sl + (size_t)s2 * 1024, __ATOMIC_RELAXED, __HIP_MEMORY_SCOPE_AGENT); }
    float hin = 0.f;
#pragma unroll
    for (int s2 = 0; s2 < 15; ++s2) if (s2 < seg) hin = __uint_as_float((unsigned)(sw[s2] >> 32)) + __uint_as_float((unsigned)sw[s2]) * hin;
    bf16* obase = mix + (rowbase + t0 + th * 128) * D + 64 * g;
    const unsigned ooff = (unsigned)(4 * q) * D + j;
#pragma unroll
    for (int mt = 0; mt < 8; ++mt)
#pragma unroll
        for (int r = 0; r < 4; ++r) { const float hv = Hl[mt][r] + Pc[mt][r] * hin;
            const float o = hv * gelu_tanh(bf2f(gtv[mt][r])); (obase + (size_t)(mt * 16 + r) * D)[ooff] = (bf16)(cvtpk(o, 0.f) & 0xffffu); }
    __syncthreads();
}

__device__ __forceinline__ void attn_unit(LAS unsigned char* lds, const bf16* __restrict__ proj, bf16* __restrict__ mix, int b, int h, int qb, float lam, float sl2,
                                          const float* __restrict__ sg, float oscale, const int tid_in) {
    constexpr int KSTR = 144, VSTR = 320, KBY = 64 * KSTR, STG = 2 * KBY + 64 * VSTR;
    const int tid = tid_in, lane = tid & 63, wid = __builtin_amdgcn_readfirstlane(tid >> 6);
    const int comp = wid >> 2, rg = wid & 3, r32 = lane & 31, hi = lane >> 5;
    const int q0 = qb * 128 + rg * 32;
    const size_t rowbase = (size_t)b * SEQ;
    const bf16* qp = proj + (rowbase + q0 + r32) * INW + 2048 + h * 128 + comp * 64 + hi * 8;
    LAS unsigned char* qs = lds + 2 * STG + wid * 4608 + r32 * KSTR + hi * 16;
    const float c1 = 0.125f * LOG2E;
#pragma unroll
    for (int d0 = 0; d0 < 4; ++d0) { const v4u qv = *(const v4u*)(qp + d0 * 16); v4u qo;
#pragma unroll
        for (int e = 0; e < 4; ++e) qo[e] = cvtpk(bflo(qv[e]) * c1, bfhi(qv[e]) * c1);
        *(LAS v4u*)(qs + d0 * 32) = qo; }
    f32x16 o[4];
#pragma unroll
    for (int vb = 0; vb < 4; ++vb)
#pragma unroll
        for (int r = 0; r < 16; ++r) o[vb][r] = 0.f;
    float mref = 0.f, l = 0.f;
    const int NT = 2 * qb + 2;
    const int krow = tid >> 3, kch = tid & 7, vrow = tid >> 4, vch = tid & 15;
    const bf16* ksrc = proj + (rowbase + krow) * INW + 3072 + h * 128 + kch * 8;
    const bf16* vsrc = proj + (rowbase + vrow) * INW + 4096 + h * 128 + vch * 8;
    v4u rk1, rk2, rv0, rv1;
#define AT_LOAD(kt) do { const size_t o_ = (size_t)(kt) * 64 * INW; rk1 = *(const v4u*)(ksrc + o_); rk2 = *(const v4u*)(ksrc + o_ + 64); rv0 = *(const v4u*)(vsrc + o_); rv1 = *(const v4u*)(vsrc + o_ + (size_t)32 * INW); } while (0)
#define AT_STORE(buf) do { LAS unsigned char* s_ = lds + (buf) * STG; *(LAS v4u*)(s_ + krow * KSTR + kch * 16) = rk1; *(LAS v4u*)(s_ + KBY + krow * KSTR + kch * 16) = rk2; \
        *(LAS v4u*)(s_ + 2 * KBY + vrow * VSTR + vch * 16) = rv0; *(LAS v4u*)(s_ + 2 * KBY + (vrow + 32) * VSTR + vch * 16) = rv1; } while (0)
    AT_LOAD(0); AT_STORE(0); __syncthreads();
    const int qpos = q0 + r32;
    for (int kt = 0; kt < NT; ++kt) {
        const bool more = kt + 1 < NT;
        if (more) AT_LOAD(kt + 1);
        if (kt * 64 <= q0 + 31) {
            LAS const unsigned char* sb = lds + (kt & 1) * STG;
            LAS const unsigned char* kc = sb + comp * KBY + r32 * KSTR + hi * 16;
            f32x16 p0, p1;
            float base = sl2 * (float)(kt * 64 + 4 * hi - qpos) - mref; asm volatile("" : "+v"(base));
#pragma unroll
            for (int r = 0; r < 16; ++r) { p0[r] = __builtin_fmaf(sl2, (float)((r & 3) + 8 * (r >> 2)), base); p1[r] = __builtin_fmaf(sl2, (float)((r & 3) + 8 * (r >> 2) + 32), base); }
#pragma unroll
            for (int d0 = 0; d0 < 4; ++d0) { const bf16x8 k0 = *(LAS const bf16x8*)(kc + d0 * 32), k1 = *(LAS const bf16x8*)(kc + 32 * KSTR + d0 * 32), qv = *(LAS const bf16x8*)(qs + d0 * 32);
                p0 = __builtin_amdgcn_mfma_f32_32x32x16_bf16(k0, qv, p0, 0, 0, 0); p1 = __builtin_amdgcn_mfma_f32_32x32x16_bf16(k1, qv, p1, 0, 0, 0); }
            if (kt * 64 + 63 > q0) { const int dqi = qpos - kt * 64 - 4 * hi;
#pragma unroll
                for (int r = 0; r < 16; ++r) { if ((r & 3) + 8 * (r >> 2) > dqi) p0[r] = -INFINITY; if ((r & 3) + 8 * (r >> 2) + 32 > dqi) p1[r] = -INFINITY; } }
            float mx = __builtin_fmaxf(__builtin_fmaxf(p0[0], p1[0]), p0[1]);
#pragma unroll
            for (int r = 1; r < 16; ++r) mx = (r == 1) ? __builtin_fmaxf(mx, p1[1]) : __builtin_fmaxf(__builtin_fmaxf(mx, p0[r]), p1[r]);
            mx = fmaxf(mx, __shfl_xor(mx, 32));
            if (__any(mx > 8.0f)) { const float dl = fmaxf(mx, 0.f), f = ex2(-dl); mref += dl; l *= f;
#pragma unroll
                for (int r = 0; r < 16; ++r) { p0[r] -= dl; p1[r] -= dl; }
#pragma unroll
                for (int vb = 0; vb < 4; ++vb)
#pragma unroll
                    for (int r = 0; r < 16; ++r) o[vb][r] *= f; }
            float ps = 0.f;
#pragma unroll
            for (int r = 0; r < 16; ++r) { p0[r] = ex2(p0[r]); p1[r] = ex2(p1[r]); ps += p0[r] + p1[r]; }
            l += ps;
            v4u pw[4];
#pragma unroll
            for (int e = 0; e < 4; ++e) { pw[0][e] = cvtpk(p0[2 * e], p0[2 * e + 1]); pw[1][e] = cvtpk(p0[8 + 2 * e], p0[9 + 2 * e]); pw[2][e] = cvtpk(p1[2 * e], p1[2 * e + 1]); pw[3][e] = cvtpk(p1[8 + 2 * e], p1[9 + 2 * e]); }
            LAS const unsigned char* vbp = sb + 2 * KBY + (4 * hi + ((lane & 15) >> 2)) * VSTR + ((lane >> 4) & 1) * 32 + (lane & 3) * 8;
#pragma unroll
            for (int s = 0; s < 4; ++s) { const bf16x8 pf = __builtin_bit_cast(bf16x8, pw[s]);
#pragma unroll
                for (int vb = 0; vb < 4; ++vb) {
                    const s16x4 lo = __builtin_bit_cast(s16x4, __builtin_amdgcn_ds_read_tr16_b64_v4i16((LAS s16x4*)(vbp + (16 * s) * VSTR + vb * 64)));
                    const s16x4 hh = __builtin_bit_cast(s16x4, __builtin_amdgcn_ds_read_tr16_b64_v4i16((LAS s16x4*)(vbp + (16 * s + 8) * VSTR + vb * 64)));
                    const bf16x8 vf = (bf16x8){lo[0], lo[1], lo[2], lo[3], hh[0], hh[1], hh[2], hh[3]};
                    o[vb] = __builtin_amdgcn_mfma_f32_32x32x16_bf16(vf, pf, o[vb], 0, 0, 0); }
                asm volatile("" ::: "memory"); }
        }
        if (more) AT_STORE((kt + 1) & 1);
        __syncthreads();
    }
#undef AT_LOAD
#undef AT_STORE
    l += __shfl_xor(l, 32);
    const float inv = 1.0f / l;
    LAS float* X = (LAS float*)lds;
    if (comp == 1) { const float sc = inv * lam;
#pragma unroll
        for (int vb = 0; vb < 4; ++vb)
#pragma unroll
            for (int r = 0; r < 16; ++r) X[(rg * 64 + vb * 16 + r) * 64 + lane] = o[vb][r] * sc; }
    __syncthreads();
    if (comp == 0) {
        float ss = 0.f;
#pragma unroll
        for (int vb = 0; vb < 4; ++vb)
#pragma unroll
            for (int r = 0; r < 16; ++r) { const float v = o[vb][r] * inv - X[(rg * 64 + vb * 16 + r) * 64 + lane]; o[vb][r] = v; ss += v * v; if ((r & 3) == 3) asm volatile("" ::: "memory"); }
        ss += __shfl_xor(ss, 32);
        const float rs = oscale / sqrtf(ss * (1.0f / 128.0f) + 1e-5f);
        LAS unsigned char* stg = lds + 65536 + rg * 8704;
#pragma unroll
        for (int vb = 0; vb < 4; ++vb)
#pragma unroll
            for (int r4 = 0; r4 < 4; ++r4) { const int v0 = 32 * vb + 8 * r4 + 4 * hi; const f32x4 g4 = *(const f32x4*)(sg + v0);
                v2u w; w.x = cvtpk(o[vb][4 * r4] * rs * g4.x, o[vb][4 * r4 + 1] * rs * g4.y); w.y = cvtpk(o[vb][4 * r4 + 2] * rs * g4.z, o[vb][4 * r4 + 3] * rs * g4.w);
                *(LAS v2u*)(stg + r32 * 272 + v0 * 2) = w; asm volatile("" ::: "memory"); }
        asm volatile("s_waitcnt lgkmcnt(0)" ::: "memory");
#pragma unroll
        for (int i = 0; i < 8; ++i) { const int c = i * 64 + lane, row = c >> 4, chn = c & 15; const v4u v = *(LAS const v4u*)(stg + row * 272 + chn * 16);
            *(v4u*)(mix + (rowbase + q0 + row) * D + 1024 + h * 128 + chn * 8) = v; }
    }
    __syncthreads();
}

#define XB_TMO      128
#define XB_XCNT(j)  (256  + 64 * (j))
#define XB_XSUB(j)  (1280 + 64 * (j))
#define XB_XGEN(j)  (2304 + 64 * (j))
#define XB_TOP      3328
#define XB_TOPGEN   3392
#define XCD_BAR_WORDS 3456
#define XB_SPIN_CAP (1u << 18)

__device__ __forceinline__ unsigned xb_ld(unsigned* p)              { return __hip_atomic_load(p, __ATOMIC_RELAXED, __HIP_MEMORY_SCOPE_AGENT); }
__device__ __forceinline__ unsigned xb_add(unsigned* p, unsigned v) { return __hip_atomic_fetch_add(p, v, __ATOMIC_RELAXED, __HIP_MEMORY_SCOPE_AGENT); }
__device__ __forceinline__ unsigned xb_xcc_id() { return (unsigned)__builtin_amdgcn_s_getreg((3 << 11) | 20) & 0xFu; }
#define XB_SPIN(cond, bar) do { unsigned _sp = 0; while (cond) { __builtin_amdgcn_s_sleep(1); \
    if ((++_sp & 255u) == 0u) { if (xb_ld(&(bar)[XB_TMO])) break; if (_sp > XB_SPIN_CAP) { atomicAdd(&(bar)[XB_TMO], 1u); break; } } } } while (0)

struct XcdBarrier {
    unsigned* bar; unsigned x;
    volatile LAS unsigned* st;
};

__device__ __forceinline__ XcdBarrier xcd_barrier_post(unsigned* bar, volatile LAS unsigned* st) {
    XcdBarrier b; b.bar = bar; b.x = xb_xcc_id(); b.st = st;
    if (threadIdx.x == 0) (void)xb_add(&bar[XB_XCNT(b.x)], 1u);
    return b;
}
__device__ __forceinline__ void xcd_barrier_complete(unsigned* bar, unsigned x, unsigned& nloc, unsigned& nx) {
    const unsigned G = gridDim.x * gridDim.y * gridDim.z;
    unsigned sum, cnt, mine, sp = 0u;
    for (;;) {
        sum = 0u; cnt = 0u; mine = 0u;
#pragma unroll
        for (unsigned j = 0; j < 16; ++j) { const unsigned c = xb_ld(&bar[XB_XCNT(j)]); sum += c; cnt += (c > 0u) ? 1u : 0u; mine = (j == x) ? c : mine; }
        if (sum == G) break;
        __builtin_amdgcn_s_sleep(1);
        if ((++sp & 255u) == 0u) { if (xb_ld(&bar[XB_TMO])) break; if (sp > XB_SPIN_CAP) { atomicAdd(&bar[XB_TMO], 1u); break; } }
    }
    nloc = mine > 0u ? mine : 1u; nx = cnt > 0u ? cnt : 1u;
}

__device__ __forceinline__ void xcd_barrier(const XcdBarrier& b, const int tid) {
    asm volatile("s_waitcnt vmcnt(0)" ::: "memory");
    __syncthreads();
    if (tid == 0) {
        unsigned* bar = b.bar;
        __builtin_amdgcn_s_waitcnt(0);
        unsigned nloc = b.st[0], nx = b.st[1];
        if (nloc == 0u) { xcd_barrier_complete(bar, b.x, nloc, nx); b.st[0] = nloc; b.st[1] = nx; }
        const unsigned old = xb_add(&bar[XB_XSUB(b.x)], 1u);
        const unsigned gen = old / nloc;
        if (old + 1u == (gen + 1u) * nloc) {
            __builtin_amdgcn_fence(__ATOMIC_RELEASE, "agent");
            asm volatile("s_waitcnt vmcnt(0)" ::: "memory");
            const unsigned og = xb_add(&bar[XB_TOP], 1u);
            const unsigned tg = og / nx;
            if (og + 1u == (tg + 1u) * nx) xb_add(&bar[XB_TOPGEN], 1u);
            else XB_SPIN(xb_ld(&bar[XB_TOPGEN]) == tg, bar);
            __builtin_amdgcn_fence(__ATOMIC_ACQUIRE, "agent");
            xb_add(&bar[XB_XGEN(b.x)], 1u);
            asm volatile("s_waitcnt vmcnt(0)" ::: "memory");
        } else {
            XB_SPIN(xb_ld(&bar[XB_XGEN(b.x)]) == gen, bar);
            __builtin_amdgcn_fence(__ATOMIC_ACQUIRE, "agent");
            asm volatile("s_waitcnt vmcnt(0)" ::: "memory");
        }
    }
    __syncthreads();
}

__global__ void __launch_bounds__(512, 2) fwd_kernel(Args a) {
    extern __shared__ __attribute__((aligned(16))) unsigned char lds_raw[];
    LAS unsigned char* lds = (LAS unsigned char*)lds_raw;
    cg::grid_group grid = cg::this_grid();
    const int G = gridDim.x;
    const int wid0 = __builtin_amdgcn_readfirstlane((int)threadIdx.x >> 6);
    unsigned char* ws = a.ws;
    bf16* XBF = (bf16*)(ws + WS_XBF); bf16* PROJ = (bf16*)(ws + WS_PROJ); bf16* MIX = (bf16*)(ws + WS_MIX); bf16* Z = (bf16*)(ws + WS_Z); bf16* HB = (bf16*)(ws + WS_H);
    float* Y = (float*)(ws + WS_Y); float* S1 = (float*)(ws + WS_S1); float* S2 = (float*)(ws + WS_S2); const float* CD = (const float*)(ws + WS_CD);
    volatile LAS unsigned* MISC = (volatile LAS unsigned*)(lds + 146432);
    if (threadIdx.x < 32) MISC[threadIdx.x] = 0u;
    __syncthreads();
    const XcdBarrier xbar = xcd_barrier_post((unsigned*)(ws + WS_CTL) + 4096, MISC + 8);
    for (int ph = a.ph_lo; ph < a.ph_hi; ++ph) {
        if (a.ph_hi > 4096) grid.sync();
        if (ph > a.ph_lo) { int wq_ = wid0; unsigned ones_ = ~0u; asm volatile("" : "+s"(wq_), "+s"(ones_));
            xcd_barrier(xbar, wq_ * 64 + (int)__builtin_amdgcn_mbcnt_hi(ones_, __builtin_amdgcn_mbcnt_lo(ones_, 0u))); }
#ifdef REP_MASK
        const int kk_ = ph == 0 ? 8 : (ph == NPHASE - 1 ? 6 : ((ph - 1) % 6)); const int nrep = ((REP_MASK >> kk_) & 1) ? 2 : 1;
        for (int rep = 0; rep < nrep; ++rep) { if (rep) xcd_barrier(xbar, (int)threadIdx.x);
#endif
        int wq = wid0; unsigned ones = ~0u; asm volatile("" : "+s"(wq), "+s"(ones));
        int tid = wq * 64 + (int)__builtin_amdgcn_mbcnt_hi(ones, __builtin_amdgcn_mbcnt_lo(ones, 0u)); asm volatile("" : "+v"(tid));
        const int l = (ph - 1) / 6, k = (ph - 1) % 6;
        if (ph == 0) {
#ifndef NO_PRO
            prologue(a, lds, G, tid);
#endif
        } else if (ph == NPHASE - 1) {
#ifndef NO_LN
            ln_phase(Y, a.in[21] + (size_t)(DEPTH - 1) * D, a.in[22] + (size_t)(DEPTH - 1) * D, a.out, G, tid);
#endif
        } else if (k == 0 || k == 3) {
            const int N = (k == 0) ? INW : FF2;
            const bf16* Bt = (k == 0) ? (const bf16*)(ws + WS_WIN) + (size_t)l * INW * D : (const bf16*)(ws + WS_WUP) + (size_t)l * FF2 * D;
            pg8::Gemm g{XBF, Bt, T, N, D}; pg8::StaticOrder S; S.init(T, N, G, (int)blockIdx.x);
            pg8::EpiBf16Ln E{(k == 0) ? PROJ : Z, N, (k == 0) ? S2 : S1, CD + (size_t)l * 32768 + (k == 0 ? 0 : 10240), CD + (size_t)l * 32768 + (k == 0 ? 5120 : 21504), lds + 131072, (k == 0 && l == 0) ? 0 : 1};
            if ((tid & 63) == 0) *((LAS int*)(lds + 131072 + 14336) + (tid >> 6)) = -1;
#ifndef NO_GEMM1
            pg8::gemm_phase<pg8::EpiBf16Ln, pg8::StaticOrder, true, true>(lds, g, S, E, tid);
#endif
        } else if (k == 2 || k == 5) {
            const int K = (k == 2) ? D : FF;
            const bf16* A = (k == 2) ? MIX : HB;
            const bf16* Bt = (k == 2) ? (const bf16*)(ws + WS_WOUT) + (size_t)l * D * D : (const bf16*)(ws + WS_WDN) + (size_t)l * D * FF;
            const bool ln = !(k == 2 && l == 0);
            const int lg = (k == 2) ? l - 1 : l;
            const float* gg = ((k == 2) ? a.in[21] : a.in[15]) + (size_t)(ln ? lg : 0) * D; const float* bb = ((k == 2) ? a.in[22] : a.in[16]) + (size_t)(ln ? lg : 0) * D;
            pg8::Gemm g{A, Bt, T, D, K}; pg8::StaticOrder S; S.init(T, D, G, (int)blockIdx.x);
            const float* gn = (k == 2) ? a.in[15] + (size_t)l * D : a.in[21] + (size_t)l * D;
#ifdef REP_MASK
            const bool dmy = (nrep == 2 && rep == 0);
            pg8::EpiResLn E{ln ? (const float*)Y : a.in[0], dmy ? (float*)(ws + 420 * MiB) : Y, dmy ? (bf16*)(ws + 388 * MiB) : XBF, D, DN_ALPHA, (k == 2) ? S2 : S1, gg, bb, gn, dmy ? (float*)(ws + 484 * MiB) : ((k == 2) ? S1 : S2), lds + 131072, ln ? 1 : 0};
#else
            pg8::EpiResLn E{ln ? (const float*)Y : a.in[0], Y, XBF, D, DN_ALPHA, (k == 2) ? S2 : S1, gg, bb, gn, (k == 2) ? S1 : S2, lds + 131072, ln ? 1 : 0};
#endif
#ifndef NO_GEMM2
            pg8::gemm_phase<pg8::EpiResLn, pg8::StaticOrder, true, true>(lds, g, S, E, tid);
#endif
        } else if (k == 4) {
#ifndef NO_CONV
            convgelu_phase(Z, a.in[18] + (size_t)l * 3 * FF2, a.in[19] + (size_t)l * FF2, HB, G, tid);
#endif
        } else {
            const int lane = tid & 63;
            const float d1 = wave_sum(a.in[9][l * 64 + lane] * a.in[10][l * 64 + lane]), d2 = wave_sum(a.in[11][l * 64 + lane] * a.in[12][l * 64 + lane]);
            const float lam_init = 0.8f - 0.6f * __expf(-0.3f * (float)l);
            const float lam = __expf(d1) - __expf(d2) + lam_init;
            unsigned* masks = (unsigned*)(ws + WS_CTL) + 1024 + l * 256;
            if (l == 0) fold_phase(a, G, tid);
#ifndef NO_RG
            for (int item = blockIdx.x; item < 512; item += G)
                rg_item(lds, item, PROJ, MIX, (const bf16*)(ws + WS_GT) + (size_t)l * 16 * 2 * 4096, a.in[2] + (size_t)l * 4096, a.in[3] + (size_t)l * 1024,
                        a.in[5] + (size_t)l * 1024, a.in[7] + (size_t)l * 1024, a.in[8] + (size_t)l * 1024, masks, (unsigned long long*)(ws + WS_SUM), tid);
#endif
#ifndef NO_ATTN
            for (int p = (G % 8 == 0) ? (int)(blockIdx.x % 8) * (G / 8) + (int)(blockIdx.x / 8) : (int)blockIdx.x; p < 256; p += G) { const int bh = p >> 3, s = p & 7, b = bh >> 3, h = bh & 7;
                const float sl2 = ex2(-(float)(h + 1)) * LOG2E;
                attn_unit(lds, PROJ, MIX, b, h, 15 - s, lam, sl2, a.in[13] + (size_t)l * 128, 1.0f - lam_init, tid);
                attn_unit(lds, PROJ, MIX, b, h, s, lam, sl2, a.in[13] + (size_t)l * 128, 1.0f - lam_init, tid); }
#endif
        }
#ifdef REP_MASK
        }
#endif
    }
#ifdef REP_SYNC
    for (int i = 0; i < REP_SYNC; ++i) xcd_barrier(xbar, (int)threadIdx.x);
#endif
}

extern "C" void kernel_launch(void* const* d_in, const int* in_sizes, int n_in, void* d_out, int out_size, void* d_ws, size_t ws_size, hipStream_t stream) {
    static int grid = 0;
    if (grid == 0) {
        if (n_in != 23 || in_sizes[0] != T * D || out_size != T * D || ws_size < WS_END) { fprintf(stderr, "kernel_launch: unexpected shapes (n_in %d, in0 %d, out %d, ws %zu)\n", n_in, n_in > 0 ? in_sizes[0] : -1, out_size, ws_size); grid = -1; return; }
        int dev = 0, cus = 0, per_cu = 0;
        hipGetDevice(&dev); hipDeviceGetAttribute(&cus, hipDeviceAttributeMultiprocessorCount, dev);
        if (hipFuncSetAttribute((const void*)fwd_kernel, hipFuncAttributeMaxDynamicSharedMemorySize, LDS_BYTES) != hipSuccess) { fprintf(stderr, "kernel_launch: hipFuncSetAttribute failed\n"); grid = -1; return; }
        if (hipOccupancyMaxActiveBlocksPerMultiprocessor(&per_cu, (const void*)fwd_kernel, 512, LDS_BYTES) != hipSuccess || per_cu < 1) { fprintf(stderr, "kernel_launch: occupancy query failed (%d)\n", per_cu); per_cu = 1; }
        (void)hipGetLastError();
        grid = cus * per_cu;
        fprintf(stderr, "kernel_launch: grid %d (cus %d x %d)\n", grid, cus, per_cu);
    }
    if (grid < 0) return;
    hipMemsetAsync((char*)d_ws + WS_CTL, 0, CTL_BYTES, stream);
    Args a{};
    for (int i = 0; i < 23; ++i) a.in[i] = (const float*)d_in[i];
    a.out = (float*)d_out; a.ws = (unsigned char*)d_ws;
#ifndef MK_SPLIT
    a.ph_lo = 0; a.ph_hi = NPHASE;
    void* args[] = {&a};
    hipError_t e = hipLaunchCooperativeKernel((const void*)fwd_kernel, dim3(grid), dim3(512), args, LDS_BYTES, stream);
    if (e != hipSuccess) fprintf(stderr, "cooperative launch failed: %s (grid %d)\n", hipGetErrorString(e), grid);
#else
    for (int ph = 0; ph < NPHASE; ++ph) { a.ph_lo = ph; a.ph_hi = ph + 1; void* args[] = {&a};
        hipError_t e = hipLaunchCooperativeKernel((const void*)fwd_kernel, dim3(grid), dim3(512), args, LDS_BYTES, stream);
        if (e != hipSuccess) { fprintf(stderr, "cooperative launch %d failed: %s (grid %d)\n", ph, hipGetErrorString(e), grid); break; } }
#endif
}
```

```cpp
#include <hip/hip_runtime.h>
#include <hip/hip_cooperative_groups.h>
#include <cstdio>
#include <cstdint>
namespace pg8 {
#define PG8_LAS __attribute__((address_space(3)))
typedef unsigned short bf16_t;
typedef short bf16x8 __attribute__((ext_vector_type(8)));
typedef float f32x4 __attribute__((ext_vector_type(4)));
typedef unsigned u32x4 __attribute__((ext_vector_type(4)));
constexpr int BM = 256, BK = 64, HALF = 128, HTB = HALF * BK * 2  , STAGE_BYTES = 8 * HTB, NXCD = 8, WGM = 8;

__host__ __device__ __forceinline__ int lds_byte(int r, int c) { const int st = (r >> 4) * 2 + (c >> 5), rr = r & 15, cc = c & 31, ob = rr * 64 + cc * 2; return st * 1024 + (ob ^ (((ob >> 9) & 1) << 5)); }
__host__ __device__ __forceinline__ void stage_rc(int b, int& R, int& C) { const int st = b / 1024, sb = b % 1024, swz = sb ^ (((sb >> 9) & 1) << 5); R = (st >> 1) * 16 + swz / 64; C = (st & 1) * 32 + (swz % 64) / 2; }
__host__ __device__ __forceinline__ int perm32(int rho) { const int n = rho >> 4, i = rho & 15; return 8 * (i >> 2) + 4 * n + (i & 3); }

struct Unit { int pm, pn; };
struct Gemm { const bf16_t* A; const bf16_t* Bt; int M, N, K; };

struct StaticOrder {
    int nM, nN, nwg, G, c;
    __host__ __device__ void init(int M, int N, int G_, int c_) { nM = M / BM; nN = N / BM; nwg = nM * nN; G = G_; c = c_; }
    __host__ __device__ bool next(int i, Unit& u) const {
        const long L = (long)i * G + c; if (L >= nwg) return false;
        int wgid = (int)L; { const int q = nwg / NXCD, r = nwg % NXCD, xcd = wgid % NXCD, off = wgid / NXCD; wgid = (xcd < r ? xcd * (q + 1) : r * (q + 1) + (xcd - r) * q) + off; }
        const int nig = WGM * nN, gid = wgid / nig, fm = gid * WGM, gsz = (nM - fm) < WGM ? (nM - fm) : WGM;
        u.pm = fm + ((wgid % nig) % gsz); u.pn = (wgid % nig) / gsz; return true;
    }
    __device__ __forceinline__ void a_ready(const Unit&) const {}
    __device__ __forceinline__ void done(const Unit&) const {}
};

typedef float cvt_f32x2_t __attribute__((ext_vector_type(2))); typedef __bf16 cvt_bf16x2_t __attribute__((ext_vector_type(2)));
__device__ __forceinline__ unsigned cvt_pk_bf16(float lo, float hi) { cvt_f32x2_t v = {lo, hi}; cvt_bf16x2_t b = __builtin_convertvector(v, cvt_bf16x2_t); return __builtin_bit_cast(unsigned, b); }
typedef float f32x2 __attribute__((ext_vector_type(2)));
__device__ __forceinline__ f32x2 gelu_pk(f32x2 v) {
    const f32x2 av = __builtin_elementwise_abs(v), d = av * 0.2316418882f + 1.0f;
    f32x2 t; t.x = __builtin_amdgcn_rcpf(d.x); t.y = __builtin_amdgcn_rcpf(d.y);
    f32x2 q = t * 0.5307027145f + (-0.7265760135f); q = q * t + 0.7107068705f; q = q * t + (-0.142248368f); q = q * t + 0.127414796f; q = q * t;
    const f32x2 s = (v * v) * (-0.72134752044f);
    f32x2 e; e.x = __builtin_amdgcn_exp2f(s.x); e.y = __builtin_amdgcn_exp2f(s.y);
    const f32x2 m = v * (q * e), r = v - m;
    f32x2 o; o.x = v.x < 0.f ? m.x : r.x; o.y = v.y < 0.f ? m.y : r.y; return o;
}

template <int ACT  > struct EpiBf16 {
    static constexpr bool PERM = true, AFTER_DRAIN = false; static_assert(ACT == 0 || ACT == 1, "EpiBf16: ACT is 0 (none) or 1 (gelu_pk)");
    bf16_t* O; int ldc; const float* bias; int split_cols; size_t split_stride; float scale0;
    __device__ __forceinline__ void operator()(const f32x4 (&acc)[2][2][4][2], const Unit& u, int wr, int wc, int fr, int fq) const {
        const int row0 = u.pm * BM + wr * 64 + fr; int colt = u.pn * BM; bf16_t* base = O;
        float sc = 1.f; if (split_cols) { const int t = colt / split_cols; base += (size_t)t * split_stride; colt -= t * split_cols; if (t == 0) sc = scale0; }
        const int col0 = colt + wc * 32 + 8 * fq, bcol0 = u.pn * BM + wc * 32 + 8 * fq;
        f32x4 bv[2][2];
#pragma unroll
        for (int bj = 0; bj < 2; ++bj)
#pragma unroll
            for (int n = 0; n < 2; ++n) bv[bj][n] = bias ? *(const f32x4*)(bias + bcol0 + bj * HALF + 4 * n) : (f32x4){0.f, 0.f, 0.f, 0.f};
#pragma unroll
        for (int ai = 0; ai < 2; ++ai)
#pragma unroll
            for (int m = 0; m < 4; ++m) { bf16_t* rowp = base + (size_t)(row0 + ai * HALF + m * 16) * ldc + col0;
#pragma unroll
                for (int bj = 0; bj < 2; ++bj) { f32x4 v0 = acc[ai][bj][m][0] + bv[bj][0], v1 = acc[ai][bj][m][1] + bv[bj][1];
                    if (ACT == 1) { f32x2 a = gelu_pk((f32x2){v0[0], v0[1]}), b = gelu_pk((f32x2){v0[2], v0[3]}), c = gelu_pk((f32x2){v1[0], v1[1]}), d = gelu_pk((f32x2){v1[2], v1[3]});
                        v0 = (f32x4){a.x, a.y, b.x, b.y}; v1 = (f32x4){c.x, c.y, d.x, d.y}; }
                    v0 = v0 * sc; v1 = v1 * sc; u32x4 w; w.x = cvt_pk_bf16(v0[0], v0[1]); w.y = cvt_pk_bf16(v0[2], v0[3]); w.z = cvt_pk_bf16(v1[0], v1[1]); w.w = cvt_pk_bf16(v1[2], v1[3]);
                    *(u32x4*)(rowp + bj * HALF) = w; } }
    }
};
constexpr int SSTR = 8192 + 32;
__device__ __forceinline__ void row_stats_table(const float* S, int pm, int wr, int lane, PG8_LAS float* tab) {
    const int half = lane >> 5, rl = (lane & 31) * 2;
    const f32x4* sp = (const f32x4*)((const f32x2*)S + (size_t)(pm * BM + half * HALF + wr * 64 + rl));
    float s0 = 0.f, q0 = 0.f, s1 = 0.f, q1 = 0.f;
#pragma unroll
    for (int b = 0; b < 4; ++b) { f32x4 v[8];
#pragma unroll
        for (int i = 0; i < 8; ++i) v[i] = sp[(size_t)(b * 8 + i) * (SSTR / 2)];
        asm volatile("" : "+v"(v[0]), "+v"(v[1]), "+v"(v[2]), "+v"(v[3]), "+v"(v[4]), "+v"(v[5]), "+v"(v[6]), "+v"(v[7]));
#pragma unroll
        for (int i = 0; i < 8; ++i) { s0 += v[i][0]; q0 += v[i][1]; s1 += v[i][2]; q1 += v[i][3]; } }
    const float m0 = s0 * (1.0f / 2048.0f), m1 = s1 * (1.0f / 2048.0f);
    f32x4 t; t[0] = m0; t[1] = 1.0f / sqrtf(q0 * (1.0f / 2048.0f) - m0 * m0 + 1e-5f); t[2] = m1; t[3] = 1.0f / sqrtf(q1 * (1.0f / 2048.0f) - m1 * m1 + 1e-5f);
    *(PG8_LAS f32x4*)(tab + (half * 64 + rl) * 2) = t;
    asm volatile("s_waitcnt lgkmcnt(0)" ::: "memory");
}
struct EpiBf16Ln {
    static constexpr bool PERM = true, AFTER_DRAIN = false;
    bf16_t* O; int ldc; const float* S; const float* cvec; const float* dvec; PG8_LAS unsigned char* ltab; int ln;
    __device__ __forceinline__ void operator()(const f32x4 (&acc)[2][2][4][2], const Unit& u, int wr, int wc, int fr, int fq) const {
        const int row0 = u.pm * BM + wr * 64 + fr, col0 = u.pn * BM + wc * 32 + 8 * fq;
        PG8_LAS float* tab = (PG8_LAS float*)(ltab + (wr * 4 + wc) * 1024);
        f32x4 cv[2][2], dv[2][2];
        if (ln) { PG8_LAS int* tag = (PG8_LAS int*)(ltab + 14336) + (wr * 4 + wc);
            if (__builtin_amdgcn_readfirstlane(*tag) != u.pm) { row_stats_table(S, u.pm, wr, fq * 16 + fr, tab); *tag = u.pm; }
#pragma unroll
            for (int bj = 0; bj < 2; ++bj)
#pragma unroll
                for (int n = 0; n < 2; ++n) { cv[bj][n] = *(const f32x4*)(cvec + col0 + bj * HALF + 4 * n); dv[bj][n] = *(const f32x4*)(dvec + col0 + bj * HALF + 4 * n); } }
#pragma unroll
        for (int ai = 0; ai < 2; ++ai)
#pragma unroll
            for (int m = 0; m < 4; ++m) { bf16_t* rowp = O + (size_t)(row0 + ai * HALF + m * 16) * ldc + col0;
                float rs = 1.f, t = 0.f; if (ln) { const float mu = tab[(ai * 64 + m * 16 + fr) * 2]; rs = tab[(ai * 64 + m * 16 + fr) * 2 + 1]; t = -rs * mu; }
#pragma unroll
                for (int bj = 0; bj < 2; ++bj) { f32x4 v0 = acc[ai][bj][m][0], v1 = acc[ai][bj][m][1];
                    if (ln) { v0 = v0 * rs + (cv[bj][0] * t + dv[bj][0]); v1 = v1 * rs + (cv[bj][1] * t + dv[bj][1]); }
                    u32x4 w; w.x = cvt_pk_bf16(v0[0], v0[1]); w.y = cvt_pk_bf16(v0[2], v0[3]); w.z = cvt_pk_bf16(v1[0], v1[1]); w.w = cvt_pk_bf16(v1[2], v1[3]);
                    *(u32x4*)(rowp + bj * HALF) = w; } }
    }
};
struct EpiResLn {
    static constexpr bool PERM = false, AFTER_DRAIN = false;
    const float* base; float* Y; bf16_t* YB; int ldc; float alpha; const float* Sin; const float* g; const float* b; const float* gn; float* So; PG8_LAS unsigned char* ltab; int ln;
    __device__ __forceinline__ void operator()(const f32x4 (&acc)[2][2][4][2], const Unit& u, int wr, int wc, int fr, int fq) const {
        const int row0 = u.pm * BM + wr * 64 + fr, col0 = u.pn * BM + wc * 32 + 4 * fq;
        PG8_LAS float* tab = (PG8_LAS float*)(ltab + (wr * 4 + wc) * 1024);
        PG8_LAS float* cvl = (PG8_LAS float*)(ltab + 8192 + (wr * 4 + wc) * 768);
        { const int lane = fq * 16 + fr, gc = u.pn * BM + (lane >> 5) * HALF + wc * 32 + (lane & 31); cvl[lane] = g[gc]; cvl[64 + lane] = b[gc]; cvl[128 + lane] = gn[gc]; }
        if (ln) row_stats_table(Sin, u.pm, wr, fq * 16 + fr, tab);
        f32x4 xb[3][2][2];
#pragma unroll
        for (int pr = 0; pr < 2; ++pr)
#pragma unroll
            for (int bj = 0; bj < 2; ++bj)
#pragma unroll
                for (int n = 0; n < 2; ++n) xb[pr][bj][n] = *(const f32x4*)(base + (size_t)(row0 + pr * 16) * ldc + col0 + bj * HALF + n * 16);
#pragma unroll
        for (int ai = 0; ai < 2; ++ai)
#pragma unroll
            for (int m = 0; m < 4; ++m) { const int ri = ai * 4 + m, row = row0 + ai * HALF + m * 16; const size_t off = (size_t)row * ldc + col0;
                if (ri < 6) { const int nrow = row0 + ((ri + 2) >> 2) * HALF + ((ri + 2) & 3) * 16;
#pragma unroll
                    for (int bj = 0; bj < 2; ++bj)
#pragma unroll
                        for (int n = 0; n < 2; ++n) xb[(ri + 2) % 3][bj][n] = *(const f32x4*)(base + (size_t)nrow * ldc + col0 + bj * HALF + n * 16); }
                float mu = 0.f, rs = 1.f; if (ln) { mu = tab[(ai * 64 + m * 16 + fr) * 2]; rs = tab[(ai * 64 + m * 16 + fr) * 2 + 1]; }
                float s = 0.f, q = 0.f;
#pragma unroll
                for (int bj = 0; bj < 2; ++bj)
#pragma unroll
                    for (int n = 0; n < 2; ++n) { f32x4 x = xb[ri % 3][bj][n]; const int ci = bj * 32 + n * 16 + 4 * fq;
                        if (ln) x = (x - mu) * rs * *(const PG8_LAS f32x4*)(cvl + ci) + *(const PG8_LAS f32x4*)(cvl + 64 + ci);
                        const f32x4 o = x * alpha + acc[ai][bj][m][n];
                        *(f32x4*)(Y + off + bj * HALF + n * 16) = o;
                        const f32x4 og = o * *(const PG8_LAS f32x4*)(cvl + 128 + ci);
                        unsigned w0 = cvt_pk_bf16(og[0], og[1]), w1 = cvt_pk_bf16(og[2], og[3]);
                        *(unsigned long long*)(YB + off + bj * HALF + n * 16) = ((unsigned long long)w1 << 32) | w0;
                        s += (o[0] + o[1]) + (o[2] + o[3]); q += (o[0] * o[0] + o[1] * o[1]) + (o[2] * o[2] + o[3] * o[3]); }
                s += __shfl_xor(s, 16); s += __shfl_xor(s, 32); q += __shfl_xor(q, 16); q += __shfl_xor(q, 32);
                if (fq == 0) { f32x2 sq; sq[0] = s; sq[1] = q; ((f32x2*)So)[(size_t)(u.pn * 4 + wc) * SSTR + row] = sq; } }
    }
};
template <class Epi, class Sched, bool ALIGN_EPI = false, bool SP2 = false>
__device__ __forceinline__ void gemm_phase(PG8_LAS unsigned char* lds, const Gemm g, const Sched& S, const Epi& E, const int tid_in) {
    const int tid = tid_in, wid = __builtin_amdgcn_readfirstlane(tid >> 6), lane = tid & 63, wr = wid >> 2, wc = wid & 3, fr = lane & 15, fq = lane >> 4;
    const int K = g.K, nt = K / BK;
    unsigned voffA[2], voffB[2];
#pragma unroll
    for (int i = 0; i < 2; ++i) { int R, C; stage_rc(tid * 16 + i * 8192, R, C); const int Rb = Epi::PERM ? ((R & ~31) + perm32(R & 31)) : R;
        voffA[i] = (unsigned)(R * K + C) * 2u; voffB[i] = (unsigned)(Rb * K + C) * 2u; }
    const size_t kstep = (size_t)(BK * 2);
    const size_t hstep = (size_t)HALF * K * 2;
    const size_t tstep = 2 * hstep;
    const unsigned ldsw = (unsigned)wid * 1024u;
    const int aoff = lds_byte(wr * 64 + fr, fq * 8), boff = lds_byte(wc * 32 + fr, fq * 8);
#define PG8_SA(b, h) (((b) * 2 + (h)) * HTB)
#define PG8_SB(b, h) ((4 + (b) * 2 + (h)) * HTB)
#define PG8_STAGE(bufoff, gbase, voff) do { _Pragma("unroll") for (int _i = 0; _i < 2; ++_i) \
        __builtin_amdgcn_global_load_lds((const unsigned*)((const char*)(gbase) + (voff)[_i]), (PG8_LAS unsigned*)(lds + (bufoff) + ldsw + _i * 8192), 16, 0, 0); } while (0)
#define PG8_LDA(dst, b, h) do { _Pragma("unroll") for (int m = 0; m < 4; ++m) _Pragma("unroll") for (int k = 0; k < 2; ++k) dst[m][k] = *(const PG8_LAS bf16x8*)(lds + PG8_SA(b, h) + aoff + m * 2048 + k * 1024); } while (0)
#define PG8_LDB(dst, b, h) do { _Pragma("unroll") for (int n = 0; n < 2; ++n) _Pragma("unroll") for (int k = 0; k < 2; ++k) dst[n][k] = *(const PG8_LAS bf16x8*)(lds + PG8_SB(b, h) + boff + n * 2048 + k * 1024); } while (0)
#define PG8_MMA(ai, bj, At, Bt) do { __builtin_amdgcn_s_setprio(1); _Pragma("unroll") for (int m = 0; m < 4; ++m) _Pragma("unroll") for (int n = 0; n < 2; ++n) _Pragma("unroll") for (int k = 0; k < 2; ++k) \
        acc[ai][bj][m][n] = __builtin_amdgcn_mfma_f32_16x16x32_bf16(Bt[n][k], At[m][k], acc[ai][bj][m][n], 0, 0, 0); __builtin_amdgcn_s_setprio(0); } while (0)
#define PG8_WAIT_V(n) asm volatile("s_waitcnt vmcnt(" #n ")" ::: "memory")
#define PG8_WAIT_L(n) asm volatile("s_waitcnt lgkmcnt(" #n ")" ::: "memory")
#define PG8_BAR __builtin_amdgcn_s_barrier()
#define PG8_SCHED __builtin_amdgcn_sched_barrier(0)
    Unit cur, nxt; int ui = 0;
    if (!S.next(0, cur)) return;
    f32x4 acc[2][2][4][2];
#pragma unroll
    for (int a = 0; a < 2; ++a)
#pragma unroll
        for (int b = 0; b < 2; ++b)
#pragma unroll
            for (int m = 0; m < 4; ++m)
#pragma unroll
                for (int n = 0; n < 2; ++n) acc[a][b][m][n] = (f32x4){0.f, 0.f, 0.f, 0.f};
    bf16x8 At[4][2], B0[2][2], B1[2][2];
    const char* cA = (const char*)g.A + (size_t)cur.pm * tstep; const char* cB = (const char*)g.Bt + (size_t)cur.pn * tstep;
    S.a_ready(cur);
    if constexpr (SP2) {
        PG8_STAGE(PG8_SB(0, 0), cB, voffB); PG8_STAGE(PG8_SB(0, 1), cB + hstep, voffB); PG8_STAGE(PG8_SA(0, 0), cA, voffA); PG8_STAGE(PG8_SA(0, 1), cA + hstep, voffA);
        if (wr == 1) PG8_BAR;
        PG8_WAIT_V(2); PG8_BAR;
        PG8_STAGE(PG8_SB(1, 0), cB + kstep, voffB); PG8_STAGE(PG8_SA(1, 0), cA + kstep, voffA); PG8_STAGE(PG8_SB(1, 1), cB + hstep + kstep, voffB);
        PG8_WAIT_V(6); PG8_BAR;
    } else {
        PG8_STAGE(PG8_SB(0, 0), cB, voffB); PG8_STAGE(PG8_SA(0, 0), cA, voffA); PG8_STAGE(PG8_SB(0, 1), cB + hstep, voffB); PG8_STAGE(PG8_SA(0, 1), cA + hstep, voffA);
        if (wr == 1) PG8_BAR;
        PG8_WAIT_V(4); PG8_BAR;
        PG8_STAGE(PG8_SB(1, 0), cB + kstep, voffB); PG8_STAGE(PG8_SA(1, 0), cA + kstep, voffA); PG8_STAGE(PG8_SB(1, 1), cB + hstep + kstep, voffB);
        PG8_WAIT_V(6); PG8_BAR;
    }
    for (;;) {
        const bool has_next = S.next(ui + 1, nxt);
        const char* nA = has_next ? (const char*)g.A + (size_t)nxt.pm * tstep : cA; const char* nB = has_next ? (const char*)g.Bt + (size_t)nxt.pn * tstep : cB;
        for (int t = 0; t < nt; t += 2) {
            const bool last = (t == nt - 2);
            const char* a1 = cA + (size_t)(t + 1) * kstep;
            const char* a2 = last ? nA : cA + (size_t)(t + 2) * kstep; const char* b2 = last ? nB : cB + (size_t)(t + 2) * kstep;
            const char* a3 = a2 + kstep; const char* b3 = b2 + kstep;
            if (last && has_next) S.a_ready(nxt);
            if constexpr (SP2) {
            PG8_LDB(B0, 0, 0); PG8_LDB(B1, 0, 1); PG8_SCHED; PG8_LDA(At, 0, 0); PG8_STAGE(PG8_SA(1, 1), a1 + hstep, voffA);
            PG8_WAIT_V(8); PG8_WAIT_L(0); PG8_BAR; PG8_MMA(0, 0, At, B0); PG8_MMA(0, 1, At, B1); PG8_BAR; PG8_SCHED;
            PG8_LDA(At, 0, 1); PG8_STAGE(PG8_SB(0, 0), b2, voffB); PG8_STAGE(PG8_SB(0, 1), b2 + hstep, voffB); PG8_STAGE(PG8_SA(0, 0), a2, voffA);
            PG8_WAIT_V(8); PG8_WAIT_L(0); PG8_BAR; PG8_MMA(1, 0, At, B0); PG8_MMA(1, 1, At, B1); PG8_BAR; PG8_SCHED;
            PG8_LDB(B0, 1, 0); PG8_LDB(B1, 1, 1); PG8_SCHED; PG8_LDA(At, 1, 0); PG8_STAGE(PG8_SA(0, 1), a2 + hstep, voffA);
            PG8_WAIT_V(8); PG8_WAIT_L(0); PG8_BAR; PG8_MMA(0, 0, At, B0); PG8_MMA(0, 1, At, B1); PG8_BAR; PG8_SCHED;
            PG8_LDA(At, 1, 1); PG8_STAGE(PG8_SB(1, 0), b3, voffB); PG8_STAGE(PG8_SB(1, 1), b3 + hstep, voffB); PG8_STAGE(PG8_SA(1, 0), a3, voffA);
            PG8_WAIT_V(8); PG8_WAIT_L(0); PG8_BAR; PG8_MMA(1, 0, At, B0); PG8_MMA(1, 1, At, B1); PG8_BAR; PG8_SCHED;
            } else {
            PG8_LDB(B0, 0, 0); PG8_SCHED; PG8_LDA(At, 0, 0); PG8_STAGE(PG8_SA(1, 1), a1 + hstep, voffA);
            PG8_WAIT_L(8); PG8_BAR; PG8_WAIT_L(0); PG8_MMA(0, 0, At, B0); PG8_BAR; PG8_SCHED;
            PG8_LDB(B1, 0, 1); PG8_STAGE(PG8_SB(0, 0), b2, voffB);
            PG8_BAR; PG8_WAIT_L(0); PG8_MMA(0, 1, At, B1); PG8_BAR;
            PG8_LDA(At, 0, 1); PG8_STAGE(PG8_SA(0, 0), a2, voffA);
            PG8_BAR; PG8_WAIT_L(0); PG8_MMA(1, 0, At, B0); PG8_BAR; PG8_SCHED;
            PG8_STAGE(PG8_SB(0, 1), b2 + hstep, voffB);
            PG8_WAIT_V(6); PG8_BAR; PG8_MMA(1, 1, At, B1); PG8_BAR;
            PG8_LDB(B0, 1, 0); PG8_SCHED; PG8_LDA(At, 1, 0); PG8_STAGE(PG8_SA(0, 1), a2 + hstep, voffA);
            PG8_WAIT_L(8); PG8_BAR; PG8_WAIT_L(0); PG8_MMA(0, 0, At, B0); PG8_BAR; PG8_SCHED;
            PG8_LDB(B1, 1, 1); PG8_STAGE(PG8_SB(1, 0), b3, voffB);
            PG8_BAR; PG8_WAIT_L(0); PG8_MMA(0, 1, At, B1); PG8_BAR;
            PG8_LDA(At, 1, 1); PG8_STAGE(PG8_SA(1, 0), a3, voffA);
            PG8_BAR; PG8_WAIT_L(0); PG8_MMA(1, 0, At, B0); PG8_BAR; PG8_SCHED;
            PG8_STAGE(PG8_SB(1, 1), b3 + hstep, voffB);
            PG8_WAIT_V(6); PG8_BAR; PG8_MMA(1, 1, At, B1); PG8_BAR;
            }
        }
        if constexpr (ALIGN_EPI) { if (wr == 0) PG8_BAR; }
        if constexpr (!Epi::AFTER_DRAIN) { E(acc, cur, wr, wc, fr, fq); S.done(cur); }
        if (!has_next) break;
#pragma unroll
        for (int a = 0; a < 2; ++a)
#pragma unroll
            for (int b = 0; b < 2; ++b)
#pragma unroll
                for (int m = 0; m < 4; ++m)
#pragma unroll
                    for (int n = 0; n < 2; ++n) acc[a][b][m][n] = (f32x4){0.f, 0.f, 0.f, 0.f};
        cur = nxt; cA = nA; cB = nB; ++ui;
        if constexpr (ALIGN_EPI) { if (wr == 1) PG8_BAR; }
    }
    PG8_WAIT_V(0);
    if constexpr (!ALIGN_EPI) { if (wr == 0) PG8_BAR; }
    PG8_BAR;
    if constexpr (Epi::AFTER_DRAIN) { E.fused(acc, cur, wr, wc, fr, fq, lds, wid, lane); S.done(cur); }
#undef PG8_SA
#undef PG8_SB
#undef PG8_STAGE
#undef PG8_LDA
#undef PG8_LDB
#undef PG8_MMA
#undef PG8_WAIT_V
#undef PG8_WAIT_L
#undef PG8_BAR
#undef PG8_SCHED
}
}
namespace cg = cooperative_groups;
#define LAS __attribute__((address_space(3)))
typedef unsigned short bf16;
typedef unsigned v4u __attribute__((ext_vector_type(4)));
typedef unsigned v2u __attribute__((ext_vector_type(2)));
typedef float f32x4 __attribute__((ext_vector_type(4)));
typedef float f32x16 __attribute__((ext_vector_type(16)));
typedef short bf16x8 __attribute__((ext_vector_type(8)));
typedef short s16x4 __attribute__((ext_vector_type(4)));

constexpr int T = 8192, SEQ = 2048, D = 2048, INW = 5120, FF = 5632, FF2 = 11264, DEPTH = 4;
constexpr int NPHASE = 2 + 6 * DEPTH;
constexpr float LOG2E = 1.4426950408889634f;
constexpr float DN_ALPHA = 1.681792830507429f;
constexpr size_t MiB = 1u << 20;
constexpr size_t WS_CTL = 0, CTL_BYTES = 1 * MiB, WS_SUM = 1 * MiB, WS_GT = 2 * MiB, WS_WIN = 4 * MiB, WS_WOUT = 84 * MiB, WS_WUP = 116 * MiB, WS_WDN = 292 * MiB,
                 WS_S1 = 404 * MiB, WS_S2 = 408 * MiB, WS_CD = 384 * MiB, WS_PCD = 386 * MiB, WS_Y = 508 * MiB, WS_XBF = 572 * MiB, WS_PROJ = 604 * MiB, WS_MIX = 684 * MiB, WS_Z = 716 * MiB, WS_H = 892 * MiB, WS_END = 980 * MiB;
constexpr int LDS_BYTES = 147456;

__device__ __forceinline__ unsigned cvtpk(float lo, float hi) { return pg8::cvt_pk_bf16(lo, hi); }
__device__ __forceinline__ float bf2f(bf16 v) { return __uint_as_float((unsigned)v << 16); }
__device__ __forceinline__ float bflo(unsigned w) { return __uint_as_float(w << 16); }
__device__ __forceinline__ float bfhi(unsigned w) { return __uint_as_float(w & 0xffff0000u); }
__device__ __forceinline__ float ex2(float x) { return __builtin_amdgcn_exp2f(x); }
__device__ __forceinline__ float rcp(float x) { return __builtin_amdgcn_rcpf(x); }
__device__ __forceinline__ float sigmoidf_(float x) { return rcp(1.0f + ex2(-LOG2E * x)); }
__device__ __forceinline__ float gelu_tanh(float x) { const float y = x * (1.0f + 0.044715f * x * x); return x * rcp(1.0f + ex2(-2.0f * 0.7978845608028654f * LOG2E * y)); }
__device__ __forceinline__ float wave_sum(float v) {
#pragma unroll
    for (int o = 1; o < 64; o <<= 1) v += __shfl_xor(v, o);
    return v;
}

__device__ __forceinline__ void transpose_item(const float* __restrict__ W, int K, int N, bf16* __restrict__ WT, LAS float* scr, int item, int lane) {
    const int nblk = N / 32, kb = item / nblk, nb = item % nblk, k0 = 64 * kb, n0 = 32 * nb;
    const float* Wb = W + (size_t)k0 * N + n0; const unsigned loff = (unsigned)(lane >> 5) * (unsigned)N + (unsigned)(lane & 31);
#pragma unroll 8
    for (int i = 0; i < 32; ++i) { const int kk = 2 * i + (lane >> 5); scr[kk * 33 + (lane & 31)] = (Wb + (size_t)(2 * i) * N)[loff]; }
    asm volatile("s_waitcnt lgkmcnt(0)" ::: "memory");
    const int c = lane & 7;
#pragma unroll
    for (int j = 0; j < 4; ++j) { const int n = (lane >> 3) + 8 * j; const LAS float* s = scr + (8 * c) * 33 + n;
        v4u o; o.x = cvtpk(s[0 * 33], s[1 * 33]); o.y = cvtpk(s[2 * 33], s[3 * 33]); o.z = cvtpk(s[4 * 33], s[5 * 33]); o.w = cvtpk(s[6 * 33], s[7 * 33]);
        *(v4u*)(WT + (size_t)(n0 + n) * K + k0 + 8 * c) = o; }
    asm volatile("s_waitcnt lgkmcnt(0)" ::: "memory");
}

__device__ __forceinline__ void fold_rows(const bf16* __restrict__ Wt, const float* __restrict__ g, const float* __restrict__ b, float* __restrict__ c, float* __restrict__ d, int r0, int r1, int lane) {
    float gr[4][8], br[4][8];
#pragma unroll
    for (int j = 0; j < 4; ++j) { const f32x4 g0 = *(const f32x4*)(g + 512 * j + 8 * lane), g1 = *(const f32x4*)(g + 512 * j + 8 * lane + 4), b0 = *(const f32x4*)(b + 512 * j + 8 * lane), b1 = *(const f32x4*)(b + 512 * j + 8 * lane + 4);
#pragma unroll
        for (int e = 0; e < 4; ++e) { gr[j][e] = g0[e]; gr[j][4 + e] = g1[e]; br[j][e] = b0[e]; br[j][4 + e] = b1[e]; } }
    for (int r = r0; r < r1; ++r) { const v4u* wp = (const v4u*)(Wt + (size_t)r * D) + lane; v4u w[4];
#pragma unroll
        for (int j = 0; j < 4; ++j) w[j] = wp[64 * j];
        float cs = 0.f, ds = 0.f;
#pragma unroll
        for (int j = 0; j < 4; ++j)
#pragma unroll
            for (int e = 0; e < 4; ++e) { const float lo = bflo(w[j][e]), hi = bfhi(w[j][e]); cs += gr[j][2 * e] * lo + gr[j][2 * e + 1] * hi; ds += br[j][2 * e] * lo + br[j][2 * e + 1] * hi; }
        cs = wave_sum(cs); ds = wave_sum(ds);
        if (lane == 0) { c[r] = cs; d[r] = ds; } }
}
struct Args { const float* in[23]; float* out; unsigned char* ws; int ph_lo, ph_hi; };

__device__ __forceinline__ void prologue(const Args& a, LAS unsigned char* lds, int G, const int tid_in) {
    const int tid = tid_in, lane = tid & 63, wave = __builtin_amdgcn_readfirstlane(tid >> 6);
    LAS float* scr = (LAS float*)(lds + wave * 16384);
    const int gw = blockIdx.x * 8 + wave, NGW = G * 8;
    unsigned char* ws = a.ws;
    constexpr int I_IN = 32 * 160, I_OUT = 32 * 64, I_UP = 32 * 352, I_DN = 88 * 64, I_L = I_IN + I_OUT + I_UP + I_DN;
    for (int it = gw; it < DEPTH * I_L; it += NGW) {
        const int l = it / I_L; int r = it % I_L;
        if (r < I_IN) { transpose_item(a.in[1] + (size_t)l * D * INW, D, INW, (bf16*)(ws + WS_WIN) + (size_t)l * INW * D, scr, r, lane); continue; } r -= I_IN;
        if (r < I_OUT) { transpose_item(a.in[14] + (size_t)l * D * D, D, D, (bf16*)(ws + WS_WOUT) + (size_t)l * D * D, scr, r, lane); continue; } r -= I_OUT;
        if (r < I_UP) { transpose_item(a.in[17] + (size_t)l * D * FF2, D, FF2, (bf16*)(ws + WS_WUP) + (size_t)l * FF2 * D, scr, r, lane); continue; } r -= I_UP;
        transpose_item(a.in[20] + (size_t)l * FF * D, FF, D, (bf16*)(ws + WS_WDN) + (size_t)l * D * FF, scr, r, lane);
    }
    const int gt = blockIdx.x * 512 + tid, NT_ = G * 512;
    { bf16* Gt = (bf16*)(ws + WS_GT);
      for (int idx = gt; idx < DEPTH * 16 * 2 * 64 * 64; idx += NT_) { const int i = idx & 63, j = (idx >> 6) & 63, mat = (idx >> 12) & 1, lg = idx >> 13;
          const float v = (mat ? a.in[6] : a.in[4])[((size_t)lg * 64 + i) * 64 + j]; Gt[idx] = (bf16)(cvtpk(v, 0.f) & 0xffffu); } }
    { const f32x4* xs = (const f32x4*)a.in[0]; v2u* xo = (v2u*)(ws + WS_XBF);
      for (int idx = gt; idx < T * D / 4; idx += NT_) { const f32x4 v = xs[idx]; v2u o; o.x = cvtpk(v.x, v.y); o.y = cvtpk(v.z, v.w); xo[idx] = o; } }
}

__device__ __forceinline__ void fold_phase(const Args& a, int G, const int tid_in) {
    const int lane = tid_in & 63, wave = __builtin_amdgcn_readfirstlane(tid_in >> 6);
    const int gw = blockIdx.x * 8 + wave, NGW = G * 8;
    constexpr int NROWS = 3 * INW + 4 * FF2;
    const int per = (NROWS + NGW - 1) / NGW; int r = gw * per; const int rend = (r + per < NROWS) ? r + per : NROWS;
    float* cd = (float*)(a.ws + WS_CD);
    while (r < rend) {
        int l, base, nrow, isup;
        if (r < 3 * INW) { l = 1 + r / INW; base = (l - 1) * INW; nrow = INW; isup = 0; } else { l = (r - 3 * INW) / FF2; base = 3 * INW + l * FF2; nrow = FF2; isup = 1; }
        const int e = (base + nrow < rend) ? base + nrow : rend;
        const bf16* Wt = isup ? (const bf16*)(a.ws + WS_WUP) + (size_t)l * FF2 * D : (const bf16*)(a.ws + WS_WIN) + (size_t)l * INW * D;
        const float* g = isup ? a.in[15] + (size_t)l * D : a.in[21] + (size_t)(l - 1) * D; const float* b = isup ? a.in[16] + (size_t)l * D : a.in[22] + (size_t)(l - 1) * D;
        float* c = cd + (size_t)l * 32768 + (isup ? 10240 : 0); float* d = cd + (size_t)l * 32768 + (isup ? 21504 : 5120);
        fold_rows(Wt, g, b, c, d, r - base, e - base, lane);
        r = e;
    }
}

__device__ __forceinline__ void ln_phase(const float* __restrict__ Y, const float* __restrict__ g, const float* __restrict__ b, float* __restrict__ outF, int G, const int tid_in) {
    const int tid = tid_in, lane = tid & 63, wave = tid >> 6;
    const int gw = blockIdx.x * 8 + wave, NGW = G * 8;
    for (int m = gw; m < T; m += NGW) {
        const f32x4* yr = (const f32x4*)(Y + (size_t)m * D) + lane;
        f32x4 v[8]; float s = 0.f;
#pragma unroll
        for (int j = 0; j < 8; ++j) { v[j] = yr[64 * j]; s += (v[j].x + v[j].y) + (v[j].z + v[j].w); }
        const float mean = wave_sum(s) * (1.f / D); float s2 = 0.f;
#pragma unroll
        for (int j = 0; j < 8; ++j) { v[j] = v[j] - mean; s2 += (v[j].x * v[j].x + v[j].y * v[j].y) + (v[j].z * v[j].z + v[j].w * v[j].w); }
        const float rstd = 1.f / sqrtf(wave_sum(s2) * (1.f / D) + 1e-5f);
        f32x4* of = (f32x4*)(outF + (size_t)m * D) + lane;
#pragma unroll
        for (int j = 0; j < 8; ++j) { const f32x4 gg = ((const f32x4*)g)[lane + 64 * j], bb = ((const f32x4*)b)[lane + 64 * j];
            const f32x4 o = v[j] * rstd * gg + bb; of[64 * j] = o; }
    }
}

__device__ __forceinline__ void convgelu_phase(const bf16* __restrict__ Z, const float* __restrict__ cw, const float* __restrict__ cb, bf16* __restrict__ H, int G, const int tid_in) {
    const int gid = blockIdx.x * 512 + tid_in, NTH = G * 512;
    constexpr int CG_ROWS = 16;
    for (int it = gid; it < (T / CG_ROWS) * (FF / 8); it += NTH) {
        const int fc = it % (FF / 8), rb = it / (FF / 8), f = fc * 8, t0 = rb * CG_ROWS;
        float wg[3][8], wu[3][8], bg[8], bu[8];
#pragma unroll
        for (int k = 0; k < 3; ++k) { const f32x4 a0 = *(const f32x4*)(cw + k * FF2 + f), a1 = *(const f32x4*)(cw + k * FF2 + f + 4), c0 = *(const f32x4*)(cw + k * FF2 + FF + f), c1 = *(const f32x4*)(cw + k * FF2 + FF + f + 4);
#pragma unroll
            for (int e = 0; e < 4; ++e) { wg[k][e] = a0[e]; wg[k][4 + e] = a1[e]; wu[k][e] = c0[e]; wu[k][4 + e] = c1[e]; } }
        { const f32x4 a0 = *(const f32x4*)(cb + f), a1 = *(const f32x4*)(cb + f + 4), c0 = *(const f32x4*)(cb + FF + f), c1 = *(const f32x4*)(cb + FF + f + 4);
#pragma unroll
          for (int e = 0; e < 4; ++e) { bg[e] = a0[e]; bg[4 + e] = a1[e]; bu[e] = c0[e]; bu[4 + e] = c1[e]; } }
        v4u g2 = {0, 0, 0, 0}, g1 = {0, 0, 0, 0}, u2 = {0, 0, 0, 0}, u1 = {0, 0, 0, 0};
        const bf16* zp = Z + (size_t)t0 * FF2 + f;
        if ((t0 & (SEQ - 1)) != 0) { g2 = *(const v4u*)(zp - 2 * (size_t)FF2); g1 = *(const v4u*)(zp - (size_t)FF2); u2 = *(const v4u*)(zp - 2 * (size_t)FF2 + FF); u1 = *(const v4u*)(zp - (size_t)FF2 + FF); }
        bf16* hp = H + (size_t)t0 * FF + f;
        for (int n4 = 0; n4 < CG_ROWS; n4 += 4) {
            v4u gq[4], uq[4];
#pragma unroll
            for (int i = 0; i < 4; ++i) { gq[i] = *(const v4u*)(zp + (size_t)(n4 + i) * FF2); uq[i] = *(const v4u*)(zp + (size_t)(n4 + i) * FF2 + FF); }
#pragma unroll
            for (int i = 0; i < 4; ++i) { const v4u g0 = gq[i], u0 = uq[i];
                float o[8];
#pragma unroll
                for (int e = 0; e < 4; ++e) {
                    const float ga = bg[2 * e] + wg[0][2 * e] * bflo(g2[e]) + wg[1][2 * e] * bflo(g1[e]) + wg[2][2 * e] * bflo(g0[e]);
                    const float gb = bg[2 * e + 1] + wg[0][2 * e + 1] * bfhi(g2[e]) + wg[1][2 * e + 1] * bfhi(g1[e]) + wg[2][2 * e + 1] * bfhi(g0[e]);
                    const float ua = bu[2 * e] + wu[0][2 * e] * bflo(u2[e]) + wu[1][2 * e] * bflo(u1[e]) + wu[2][2 * e] * bflo(u0[e]);
                    const float ub = bu[2 * e + 1] + wu[0][2 * e + 1] * bfhi(u2[e]) + wu[1][2 * e + 1] * bfhi(u1[e]) + wu[2][2 * e + 1] * bfhi(u0[e]);
                    o[2 * e] = gelu_tanh(ga) * ua; o[2 * e + 1] = gelu_tanh(gb) * ub;
                }
                v4u w; w.x = cvtpk(o[0], o[1]); w.y = cvtpk(o[2], o[3]); w.z = cvtpk(o[4], o[5]); w.w = cvtpk(o[6], o[7]);
                *(v4u*)(hp + (size_t)(n4 + i) * FF) = w;
                g2 = g1; g1 = g0; u2 = u1; u1 = u0; }
        }
    }
}

__device__ __forceinline__ void rg_item(LAS unsigned char* lds, int item, const bf16* __restrict__ proj, bf16* __restrict__ mix, const bf16* __restrict__ Gt,
                                        const float* __restrict__ conv_w, const float* __restrict__ conv_b, const float* __restrict__ ba, const float* __restrict__ bx,
                                        const float* __restrict__ lamp, unsigned* masks, unsigned long long* slots, const int tid_in) {
    const int tid = tid_in, lane = tid & 63, wid = __builtin_amdgcn_readfirstlane(tid >> 6);
    const int kblk = item >> 6, bg = item & 63, b = bg >> 4, g = bg & 15, t0 = kblk * 256;
    const size_t rowbase = (size_t)b * SEQ;
    LAS float* U = (LAS float*)lds;
    LAS unsigned char* RAW = lds + 69632;
    { const bf16* xg = proj + rowbase * INW + 64 * g; v4u rawv[5];
#pragma unroll
      for (int i5 = 0; i5 < 5; ++i5) { const int c = tid + 512 * i5, r = c >> 3, t = t0 - 3 + r; rawv[i5] = (v4u){0u, 0u, 0u, 0u};
          if (c < 259 * 8 && t >= 0) rawv[i5] = *(const v4u*)(xg + (size_t)t * INW + (c & 7) * 8); }
#pragma unroll
      for (int i5 = 0; i5 < 5; ++i5) { const int c = tid + 512 * i5; if (c < 259 * 8) *(LAS v4u*)(RAW + c * 16) = rawv[i5]; } }
    __syncthreads();
    { const int i = tid & 63, run = tid >> 6, ch = 64 * g + i;
      const float w0 = conv_w[ch], w1 = conv_w[1024 + ch], w2 = conv_w[2048 + ch], w3 = conv_w[3072 + ch], cbv = conv_b[ch];
      const LAS bf16* xr = (const LAS bf16*)RAW + (run * 32) * 64 + i;
      float x0 = bf2f(xr[0]), x1 = bf2f(xr[64]), x2 = bf2f(xr[128]);
#pragma unroll 8
      for (int n = 0; n < 32; ++n) { const float x3 = bf2f(xr[(n + 3) * 64]); U[(run * 32 + n) * 68 + i] = cbv + w0 * x0 + w1 * x1 + w2 * x2 + w3 * x3; x0 = x1; x1 = x2; x2 = x3; } }
    __syncthreads();
    const int cb = wid & 3, th = wid >> 2, seg = kblk * 2 + th;
    const int q = lane >> 4, c16 = lane & 15, j = 16 * cb + c16, ch = 64 * g + j;
    const bf16* gp = Gt + ((size_t)(g * 2) * 64 + j) * 64 + 8 * q;
    bf16x8 Ba[2], Bx[2];
#pragma unroll
    for (int s = 0; s < 2; ++s) { Ba[s] = *(const bf16x8*)(gp + 32 * s); Bx[s] = *(const bf16x8*)(gp + 4096 + 32 * s); }
    const float bav = ba[ch], bxv = bx[ch];
    const float c2 = -8.0f * log1pf(__expf(-lamp[ch])) * LOG2E;
    const bf16* gbase = proj + (rowbase + t0 + th * 128) * INW + 1024 + 64 * g;
    const unsigned goff = (unsigned)(4 * q) * INW + j;
    bf16 gtv[8][4];
#pragma unroll
    for (int mt = 0; mt < 8; ++mt)
#pragma unroll
        for (int r = 0; r < 4; ++r) gtv[mt][r] = (gbase + (size_t)(mt * 16 + r) * INW)[goff];
    asm volatile("" ::: "memory");
    float Hl[8][4], Pc[8][4]; float cP = 1.f, cH = 0.f;
#pragma unroll
    for (int mt = 0; mt < 8; ++mt) {
        const int rt = th * 128 + mt * 16;
        const LAS float* ur = U + (rt + c16) * 68 + 8 * q;
        const f32x4 a0 = *(const LAS f32x4*)(ur), a1 = *(const LAS f32x4*)(ur + 4), a2 = *(const LAS f32x4*)(ur + 32), a3 = *(const LAS f32x4*)(ur + 36);
        v4u A0u, A1u; A0u.x = cvtpk(a0.x, a0.y); A0u.y = cvtpk(a0.z, a0.w); A0u.z = cvtpk(a1.x, a1.y); A0u.w = cvtpk(a1.z, a1.w);
        A1u.x = cvtpk(a2.x, a2.y); A1u.y = cvtpk(a2.z, a2.w); A1u.z = cvtpk(a3.x, a3.y); A1u.w = cvtpk(a3.z, a3.w);
        const bf16x8 A0 = __builtin_bit_cast(bf16x8, A0u), A1 = __builtin_bit_cast(bf16x8, A1u);
        f32x4 accr = {0.f, 0.f, 0.f, 0.f}, acci = {0.f, 0.f, 0.f, 0.f};
        accr = __builtin_amdgcn_mfma_f32_16x16x32_bf16(A0, Ba[0], accr, 0, 0, 0); accr = __builtin_amdgcn_mfma_f32_16x16x32_bf16(A1, Ba[1], accr, 0, 0, 0);
        acci = __builtin_amdgcn_mfma_f32_16x16x32_bf16(A0, Bx[0], acci, 0, 0, 0); acci = __builtin_amdgcn_mfma_f32_16x16x32_bf16(A1, Bx[1], acci, 0, 0, 0);
        float av[4], bv[4];
#pragma unroll
        for (int r = 0; r < 4; ++r) {
            const float u = U[(rt + 4 * q + r) * 68 + j];
            const float rr = sigmoidf_(accr[r] + bav), ig = sigmoidf_(acci[r] + bxv);
            const float l2a = c2 * rr, a = ex2(l2a), x = 2.0f * 0.6931471805599453f * l2a;
            const float om = (x > -0.02f) ? -x * (1.0f + x * (0.5f + x * (1.0f / 6.0f))) : 1.0f - a * a;
            av[r] = a; bv[r] = sqrtf(om) * ig * u;
        }
        float A_ = av[0], H_ = bv[0]; Pc[mt][0] = A_; Hl[mt][0] = H_;
#pragma unroll
        for (int r = 1; r < 4; ++r) { H_ = av[r] * H_ + bv[r]; A_ *= av[r]; Pc[mt][r] = A_; Hl[mt][r] = H_; }
        float tA = A_, tH = H_;
        { const float pA = __shfl_up(tA, 16), pH = __shfl_up(tH, 16); if (q >= 1) { tH = tA * pH + tH; tA = tA * pA; } }
        { const float pA = __shfl_up(tA, 32), pH = __shfl_up(tH, 32); if (q >= 2) { tH = tA * pH + tH; tA = tA * pA; } }
        float eA = __shfl_up(tA, 16), eH = __shfl_up(tH, 16); if (q == 0) { eA = 1.f; eH = 0.f; }
        const float inA = cP * eA, inH = eA * cH + eH;
#pragma unroll
        for (int r = 0; r < 4; ++r) { Hl[mt][r] = Pc[mt][r] * inH + Hl[mt][r]; Pc[mt][r] = Pc[mt][r] * inA; }
        const float totA = __shfl(tA, 48 + c16), totH = __shfl(tH, 48 + c16);
        cH = totA * cH + totH; cP = cP * totA;
        asm volatile("" ::: "memory");
    }
    unsigned long long* sl = slots + ((size_t)b * 16) * 1024 + ch;
    if (q == 0) __hip_atomic_store(sl + (size_t)seg * 1024, ((unsigned long long)__float_as_uint(cH) << 32) | __float_as_uint(cP), __ATOMIC_RELAXED, __HIP_MEMORY_SCOPE_AGENT);
    asm volatile("s_waitcnt vmcnt(0)" ::: "memory");
    unsigned* mk = masks + bg * 4 + cb;
    if (lane == 0) __hip_atomic_fetch_or(mk, 1u << seg, __ATOMIC_RELAXED, __HIP_MEMORY_SCOPE_AGENT);
    const unsigned need = (1u << seg) - 1u;
    if (need) { unsigned sp = 0;
        while (((unsigned)__builtin_amdgcn_readfirstlane(__hip_atomic_load(mk, __ATOMIC_RELAXED, __HIP_MEMORY_SCOPE_AGENT)) & need) != need) { __builtin_amdgcn_s_sleep(2); if (++sp > (1u << 22)) break; }
        asm volatile("" ::: "memory"); }
    unsigned long long sw[15];
#pragma unroll
    for (int s2 = 0; s2 < 15; ++s2) { sw[s2] = 0ull; if (s2 < seg) sw[s2] = __hip_atomic_load(sl + (size_t)s2 * 1024, __ATOMIC_RELAXED, __HIP_MEMORY_SCOPE_AGENT); }
    float hin = 0.f;
#pragma unroll
    for (int s2 = 0; s2 < 15; ++s2) if (s2 < seg) hin = __uint_as_float((unsigned)(sw[s2] >> 32)) + __uint_as_float((unsigned)sw[s2]) * hin;
    bf16* obase = mix + (rowbase + t0 + th * 128) * D + 64 * g;
    const unsigned ooff = (unsigned)(4 * q) * D + j;
#pragma unroll
    for (int mt = 0; mt < 8; ++mt)
#pragma unroll
        for (int r = 0; r < 4; ++r) { const float hv = Hl[mt][r] + Pc[mt][r] * hin;
            const float o = hv * gelu_tanh(bf2f(gtv[mt][r])); (obase + (size_t)(mt * 16 + r) * D)[ooff] = (bf16)(cvtpk(o, 0.f) & 0xffffu); }
    __syncthreads();
}

__device__ __forceinline__ void attn_unit(LAS unsigned char* lds, const bf16* __restrict__ proj, bf16* __restrict__ mix, int b, int h, int qb, float lam, float sl2,
                                          const float* __restrict__ sg, float oscale, const int tid_in) {
    constexpr int KSTR = 144, VSTR = 320, KBY = 64 * KSTR, STG = 2 * KBY + 64 * VSTR;
    const int tid = tid_in, lane = tid & 63, wid = __builtin_amdgcn_readfirstlane(tid >> 6);
    const int comp = wid >> 2, rg = wid & 3, r32 = lane & 31, hi = lane >> 5;
    const int q0 = qb * 128 + rg * 32;
    const size_t rowbase = (size_t)b * SEQ;
    const bf16* qp = proj + (rowbase + q0 + r32) * INW + 2048 + h * 128 + comp * 64 + hi * 8;
    LAS unsigned char* qs = lds + 2 * STG + wid * 4608 + r32 * KSTR + hi * 16;
    const float c1 = 0.125f * LOG2E;
#pragma unroll
    for (int d0 = 0; d0 < 4; ++d0) { const v4u qv = *(const v4u*)(qp + d0 * 16); v4u qo;
#pragma unroll
        for (int e = 0; e < 4; ++e) qo[e] = cvtpk(bflo(qv[e]) * c1, bfhi(qv[e]) * c1);
        *(LAS v4u*)(qs + d0 * 32) = qo; }
    f32x16 o[4];
#pragma unroll
    for (int vb = 0; vb < 4; ++vb)
#pragma unroll
        for (int r = 0; r < 16; ++r) o[vb][r] = 0.f;
    float mref = 0.f, l = 0.f;
    const int NT = 2 * qb + 2;
    const int krow = tid >> 3, kch = tid & 7, vrow = tid >> 4, vch = tid & 15;
    const bf16* ksrc = proj + (rowbase + krow) * INW + 3072 + h * 128 + kch * 8;
    const bf16* vsrc = proj + (rowbase + vrow) * INW + 4096 + h * 128 + vch * 8;
    v4u rk1, rk2, rv0, rv1;
#define AT_LOAD(kt) do { const size_t o_ = (size_t)(kt) * 64 * INW; rk1 = *(const v4u*)(ksrc + o_); rk2 = *(const v4u*)(ksrc + o_ + 64); rv0 = *(const v4u*)(vsrc + o_); rv1 = *(const v4u*)(vsrc + o_ + (size_t)32 * INW); } while (0)
#define AT_STORE(buf) do { LAS unsigned char* s_ = lds + (buf) * STG; *(LAS v4u*)(s_ + krow * KSTR + kch * 16) = rk1; *(LAS v4u*)(s_ + KBY + krow * KSTR + kch * 16) = rk2; \
        *(LAS v4u*)(s_ + 2 * KBY + vrow * VSTR + vch * 16) = rv0; *(LAS v4u*)(s_ + 2 * KBY + (vrow + 32) * VSTR + vch * 16) = rv1; } while (0)
    AT_LOAD(0); AT_STORE(0); __syncthreads();
    const int qpos = q0 + r32;
    for (int kt = 0; kt < NT; ++kt) {
        const bool more = kt + 1 < NT;
        if (more) AT_LOAD(kt + 1);
        if (kt * 64 <= q0 + 31) {
            LAS const unsigned char* sb = lds + (kt & 1) * STG;
            LAS const unsigned char* kc = sb + comp * KBY + r32 * KSTR + hi * 16;
            f32x16 p0, p1;
            float base = sl2 * (float)(kt * 64 + 4 * hi - qpos) - mref; asm volatile("" : "+v"(base));
#pragma unroll
            for (int r = 0; r < 16; ++r) { p0[r] = __builtin_fmaf(sl2, (float)((r & 3) + 8 * (r >> 2)), base); p1[r] = __builtin_fmaf(sl2, (float)((r & 3) + 8 * (r >> 2) + 32), base); }
#pragma unroll
            for (int d0 = 0; d0 < 4; ++d0) { const bf16x8 k0 = *(LAS const bf16x8*)(kc + d0 * 32), k1 = *(LAS const bf16x8*)(kc + 32 * KSTR + d0 * 32), qv = *(LAS const bf16x8*)(qs + d0 * 32);
                p0 = __builtin_amdgcn_mfma_f32_32x32x16_bf16(k0, qv, p0, 0, 0, 0); p1 = __builtin_amdgcn_mfma_f32_32x32x16_bf16(k1, qv, p1, 0, 0, 0); }
            if (kt * 64 + 63 > q0) { const int dqi = qpos - kt * 64 - 4 * hi;
#pragma unroll
                for (int r = 0; r < 16; ++r) { if ((r & 3) + 8 * (r >> 2) > dqi) p0[r] = -INFINITY; if ((r & 3) + 8 * (r >> 2) + 32 > dqi) p1[r] = -INFINITY; } }
            float mx = __builtin_fmaxf(__builtin_fmaxf(p0[0], p1[0]), p0[1]);
#pragma unroll
            for (int r = 1; r < 16; ++r) mx = (r == 1) ? __builtin_fmaxf(mx, p1[1]) : __builtin_fmaxf(__builtin_fmaxf(mx, p0[r]), p1[r]);
            mx = fmaxf(mx, __shfl_xor(mx, 32));
            if (__any(mx > 8.0f)) { const float dl = fmaxf(mx, 0.f), f = ex2(-dl); mref += dl; l *= f;
#pragma unroll
                for (int r = 0; r < 16; ++r) { p0[r] -= dl; p1[r] -= dl; }
#pragma unroll
                for (int vb = 0; vb < 4; ++vb)
#pragma unroll
                    for (int r = 0; r < 16; ++r) o[vb][r] *= f; }
            float ps = 0.f;
#pragma unroll
            for (int r = 0; r < 16; ++r) { p0[r] = ex2(p0[r]); p1[r] = ex2(p1[r]); ps += p0[r] + p1[r]; }
            l += ps;
            v4u pw[4];
#pragma unroll
            for (int e = 0; e < 4; ++e) { pw[0][e] = cvtpk(p0[2 * e], p0[2 * e + 1]); pw[1][e] = cvtpk(p0[8 + 2 * e], p0[9 + 2 * e]); pw[2][e] = cvtpk(p1[2 * e], p1[2 * e + 1]); pw[3][e] = cvtpk(p1[8 + 2 * e], p1[9 + 2 * e]); }
            LAS const unsigned char* vbp = sb + 2 * KBY + (4 * hi + ((lane & 15) >> 2)) * VSTR + ((lane >> 4) & 1) * 32 + (lane & 3) * 8;
#pragma unroll
            for (int s = 0; s < 4; ++s) { const bf16x8 pf = __builtin_bit_cast(bf16x8, pw[s]);
#pragma unroll
                for (int vb = 0; vb < 4; ++vb) {
                    const s16x4 lo = __builtin_bit_cast(s16x4, __builtin_amdgcn_ds_read_tr16_b64_v4i16((LAS s16x4*)(vbp + (16 * s) * VSTR + vb * 64)));
                    const s16x4 hh = __builtin_bit_cast(s16x4, __builtin_amdgcn_ds_read_tr16_b64_v4i16((LAS s16x4*)(vbp + (16 * s + 8) * VSTR + vb * 64)));
                    const bf16x8 vf = (bf16x8){lo[0], lo[1], lo[2], lo[3], hh[0], hh[1], hh[2], hh[3]};
                    o[vb] = __builtin_amdgcn_mfma_f32_32x32x16_bf16(vf, pf, o[vb], 0, 0, 0); }
                asm volatile("" ::: "memory"); }
        }
        if (more) AT_STORE((kt + 1) & 1);
        __syncthreads();
    }
#undef AT_LOAD
#undef AT_STORE
    l += __shfl_xor(l, 32);
    const float inv = 1.0f / l;
    LAS float* X = (LAS float*)lds;
    if (comp == 1) { const float sc = inv * lam;
#pragma unroll
        for (int vb = 0; vb < 4; ++vb)
#pragma unroll
            for (int r = 0; r < 16; ++r) X[(rg * 64 + vb * 16 + r) * 64 + lane] = o[vb][r] * sc; }
    __syncthreads();
    if (comp == 0) {
        float ss = 0.f;
#pragma unroll
        for (int vb = 0; vb < 4; ++vb)
#pragma unroll
            for (int r = 0; r < 16; ++r) { const float v = o[vb][r] * inv - X[(rg * 64 + vb * 16 + r) * 64 + lane]; o[vb][r] = v; ss += v * v; if ((r & 3) == 3) asm volatile("" ::: "memory"); }
        ss += __shfl_xor(ss, 32);
        const float rs = oscale / sqrtf(ss * (1.0f / 128.0f) + 1e-5f);
        LAS unsigned char* stg = lds + 65536 + rg * 8704;
#pragma unroll
        for (int vb = 0; vb < 4; ++vb)
#pragma unroll
            for (int r4 = 0; r4 < 4; ++r4) { const int v0 = 32 * vb + 8 * r4 + 4 * hi; const f32x4 g4 = *(const f32x4*)(sg + v0);
                v2u w; w.x = cvtpk(o[vb][4 * r4] * rs * g4.x, o[vb][4 * r4 + 1] * rs * g4.y); w.y = cvtpk(o[vb][4 * r4 + 2] * rs * g4.z, o[vb][4 * r4 + 3] * rs * g4.w);
                *(LAS v2u*)(stg + r32 * 272 + v0 * 2) = w; asm volatile("" ::: "memory"); }
        asm volatile("s_waitcnt lgkmcnt(0)" ::: "memory");
#pragma unroll
        for (int i = 0; i < 8; ++i) { const int c = i * 64 + lane, row = c >> 4, chn = c & 15; const v4u v = *(LAS const v4u*)(stg + row * 272 + chn * 16);
            *(v4u*)(mix + (rowbase + q0 + row) * D + 1024 + h * 128 + chn * 8) = v; }
    }
    __syncthreads();
}

#define XB_TMO      128
#define XB_XCNT(j)  (256  + 64 * (j))
#define XB_XSUB(j)  (1280 + 64 * (j))
#define XB_XGEN(j)  (2304 + 64 * (j))
#define XB_TOP      3328
#define XB_TOPGEN   3392
#define XCD_BAR_WORDS 3456
#define XB_SPIN_CAP (1u << 18)

__device__ __forceinline__ unsigned xb_ld(unsigned* p)              { return __hip_atomic_load(p, __ATOMIC_RELAXED, __HIP_MEMORY_SCOPE_AGENT); }
__device__ __forceinline__ unsigned xb_add(unsigned* p, unsigned v) { return __hip_atomic_fetch_add(p, v, __ATOMIC_RELAXED, __HIP_MEMORY_SCOPE_AGENT); }
__device__ __forceinline__ unsigned xb_xcc_id() { return (unsigned)__builtin_amdgcn_s_getreg((3 << 11) | 20) & 0xFu; }
#define XB_SPIN(cond, bar) do { unsigned _sp = 0; while (cond) { __builtin_amdgcn_s_sleep(1); \
    if ((++_sp & 255u) == 0u) { if (xb_ld(&(bar)[XB_TMO])) break; if (_sp > XB_SPIN_CAP) { atomicAdd(&(bar)[XB_TMO], 1u); break; } } } } while (0)

struct XcdBarrier {
    unsigned* bar; unsigned x;
    volatile LAS unsigned* st;
};

__device__ __forceinline__ XcdBarrier xcd_barrier_post(unsigned* bar, volatile LAS unsigned* st) {
    XcdBarrier b; b.bar = bar; b.x = xb_xcc_id(); b.st = st;
    if (threadIdx.x == 0) (void)xb_add(&bar[XB_XCNT(b.x)], 1u);
    return b;
}
__device__ __forceinline__ void xcd_barrier_complete(unsigned* bar, unsigned x, unsigned& nloc, unsigned& nx) {
    const unsigned G = gridDim.x * gridDim.y * gridDim.z;
    unsigned sum, cnt, mine, sp = 0u;
    for (;;) {
        sum = 0u; cnt = 0u; mine = 0u;
#pragma unroll
        for (unsigned j = 0; j < 16; ++j) { const unsigned c = xb_ld(&bar[XB_XCNT(j)]); sum += c; cnt += (c > 0u) ? 1u : 0u; mine = (j == x) ? c : mine; }
        if (sum == G) break;
        __builtin_amdgcn_s_sleep(1);
        if ((++sp & 255u) == 0u) { if (xb_ld(&bar[XB_TMO])) break; if (sp > XB_SPIN_CAP) { atomicAdd(&bar[XB_TMO], 1u); break; } }
    }
    nloc = mine > 0u ? mine : 1u; nx = cnt > 0u ? cnt : 1u;
}

__device__ __forceinline__ void xcd_barrier(const XcdBarrier& b, const int tid) {
    asm volatile("s_waitcnt vmcnt(0)" ::: "memory");
    __syncthreads();
    if (tid == 0) {
        unsigned* bar = b.bar;
        __builtin_amdgcn_s_waitcnt(0);
        unsigned nloc = b.st[0], nx = b.st[1];
        if (nloc == 0u) { xcd_barrier_complete(bar, b.x, nloc, nx); b.st[0] = nloc; b.st[1] = nx; }
        const unsigned old = xb_add(&bar[XB_XSUB(b.x)], 1u);
        const unsigned gen = old / nloc;
        if (old + 1u == (gen + 1u) * nloc) {
            __builtin_amdgcn_fence(__ATOMIC_RELEASE, "agent");
            asm volatile("s_waitcnt vmcnt(0)" ::: "memory");
            const unsigned og = xb_add(&bar[XB_TOP], 1u);
            const unsigned tg = og / nx;
            if (og + 1u == (tg + 1u) * nx) xb_add(&bar[XB_TOPGEN], 1u);
            else XB_SPIN(xb_ld(&bar[XB_TOPGEN]) == tg, bar);
            __builtin_amdgcn_fence(__ATOMIC_ACQUIRE, "agent");
            xb_add(&bar[XB_XGEN(b.x)], 1u);
            asm volatile("s_waitcnt vmcnt(0)" ::: "memory");
        } else {
            XB_SPIN(xb_ld(&bar[XB_XGEN(b.x)]) == gen, bar);
            __builtin_amdgcn_fence(__ATOMIC_ACQUIRE, "agent");
            asm volatile("s_waitcnt vmcnt(0)" ::: "memory");
        }
    }
    __syncthreads();
}

__global__ void __launch_bounds__(512, 2) fwd_kernel(Args a) {
    extern __shared__ __attribute__((aligned(16))) unsigned char lds_raw[];
    LAS unsigned char* lds = (LAS unsigned char*)lds_raw;
    cg::grid_group grid = cg::this_grid();
    const int G = gridDim.x;
    const int wid0 = __builtin_amdgcn_readfirstlane((int)threadIdx.x >> 6);
    unsigned char* ws = a.ws;
    bf16* XBF = (bf16*)(ws + WS_XBF); bf16* PROJ = (bf16*)(ws + WS_PROJ); bf16* MIX = (bf16*)(ws + WS_MIX); bf16* Z = (bf16*)(ws + WS_Z); bf16* HB = (bf16*)(ws + WS_H);
    float* Y = (float*)(ws + WS_Y); float* S1 = (float*)(ws + WS_S1); float* S2 = (float*)(ws + WS_S2); const float* CD = (const float*)(ws + WS_CD);
    volatile LAS unsigned* MISC = (volatile LAS unsigned*)(lds + 146432);
    if (threadIdx.x < 32) MISC[threadIdx.x] = 0u;
    __syncthreads();
    const XcdBarrier xbar = xcd_barrier_post((unsigned*)(ws + WS_CTL) + 4096, MISC + 8);
    for (int ph = a.ph_lo; ph < a.ph_hi; ++ph) {
        if (a.ph_hi > 4096) grid.sync();
        if (ph > a.ph_lo) { int wq_ = wid0; unsigned ones_ = ~0u; asm volatile("" : "+s"(wq_), "+s"(ones_));
            xcd_barrier(xbar, wq_ * 64 + (int)__builtin_amdgcn_mbcnt_hi(ones_, __builtin_amdgcn_mbcnt_lo(ones_, 0u))); }
#ifdef REP_MASK
        const int kk_ = ph == 0 ? 8 : (ph == NPHASE - 1 ? 6 : ((ph - 1) % 6)); const int nrep = ((REP_MASK >> kk_) & 1) ? 2 : 1;
        for (int rep = 0; rep < nrep; ++rep) { if (rep) xcd_barrier(xbar, (int)threadIdx.x);
#endif
        int wq = wid0; unsigned ones = ~0u; asm volatile("" : "+s"(wq), "+s"(ones));
        int tid = wq * 64 + (int)__builtin_amdgcn_mbcnt_hi(ones, __builtin_amdgcn_mbcnt_lo(ones, 0u)); asm volatile("" : "+v"(tid));
        const int l = (ph - 1) / 6, k = (ph - 1) % 6;
        if (ph == 0) {
#ifndef NO_PRO
            prologue(a, lds, G, tid);
#endif
        } else if (ph == NPHASE - 1) {
#ifndef NO_LN
            ln_phase(Y, a.in[21] + (size_t)(DEPTH - 1) * D, a.in[22] + (size_t)(DEPTH - 1) * D, a.out, G, tid);
#endif
        } else if (k == 0 || k == 3) {
            const int N = (k == 0) ? INW : FF2;
            const bf16* Bt = (k == 0) ? (const bf16*)(ws + WS_WIN) + (size_t)l * INW * D : (const bf16*)(ws + WS_WUP) + (size_t)l * FF2 * D;
            pg8::Gemm g{XBF, Bt, T, N, D}; pg8::StaticOrder S; S.init(T, N, G, (int)blockIdx.x);
            pg8::EpiBf16Ln E{(k == 0) ? PROJ : Z, N, (k == 0) ? S2 : S1, CD + (size_t)l * 32768 + (k == 0 ? 0 : 10240), CD + (size_t)l * 32768 + (k == 0 ? 5120 : 21504), lds + 131072, (k == 0 && l == 0) ? 0 : 1};
            if ((tid & 63) == 0) *((LAS int*)(lds + 131072 + 14336) + (tid >> 6)) = -1;
#ifndef NO_GEMM1
            pg8::gemm_phase<pg8::EpiBf16Ln, pg8::StaticOrder, true, true>(lds, g, S, E, tid);
#endif
        } else if (k == 2 || k == 5) {
            const int K = (k == 2) ? D : FF;
            const bf16* A = (k == 2) ? MIX : HB;
            const bf16* Bt = (k == 2) ? (const bf16*)(ws + WS_WOUT) + (size_t)l * D * D : (const bf16*)(ws + WS_WDN) + (size_t)l * D * FF;
            const bool ln = !(k == 2 && l == 0);
            const int lg = (k == 2) ? l - 1 : l;
            const float* gg = ((k == 2) ? a.in[21] : a.in[15]) + (size_t)(ln ? lg : 0) * D; const float* bb = ((k == 2) ? a.in[22] : a.in[16]) + (size_t)(ln ? lg : 0) * D;
            pg8::Gemm g{A, Bt, T, D, K}; pg8::StaticOrder S; S.init(T, D, G, (int)blockIdx.x);
            const float* gn = (k == 2) ? a.in[15] + (size_t)l * D : a.in[21] + (size_t)l * D;
#ifdef REP_MASK
            const bool dmy = (nrep == 2 && rep == 0);
            pg8::EpiResLn E{ln ? (const float*)Y : a.in[0], dmy ? (float*)(ws + 420 * MiB) : Y, dmy ? (bf16*)(ws + 388 * MiB) : XBF, D, DN_ALPHA, (k == 2) ? S2 : S1, gg, bb, gn, dmy ? (float*)(ws + 484 * MiB) : ((k == 2) ? S1 : S2), lds + 131072, ln ? 1 : 0};
#else
            pg8::EpiResLn E{ln ? (const float*)Y : a.in[0], Y, XBF, D, DN_ALPHA, (k == 2) ? S2 : S1, gg, bb, gn, (k == 2) ? S1 : S2, lds + 131072, ln ? 1 : 0};
#endif
#ifndef NO_GEMM2
            pg8::gemm_phase<pg8::EpiResLn, pg8::StaticOrder, true, true>(lds, g, S, E, tid);
#endif
        } else if (k == 4) {
#ifndef NO_CONV
            convgelu_phase(Z, a.in[18] + (size_t)l * 3 * FF2, a.in[19] + (size_t)l * FF2, HB, G, tid);
#endif
        } else {
            const int lane = tid & 63;
            const float d1 = wave_sum(a.in[9][l * 64 + lane] * a.in[10][l * 64 + lane]), d2 = wave_sum(a.in[11][l * 64 + lane] * a.in[12][l * 64 + lane]);
            const float lam_init = 0.8f - 0.6f * __expf(-0.3f * (float)l);
            const float lam = __expf(d1) - __expf(d2) + lam_init;
            unsigned* masks = (unsigned*)(ws + WS_CTL) + 1024 + l * 256;
#ifndef NO_RG
            for (int item = blockIdx.x; item < 512; item += G)
                rg_item(lds, item, PROJ, MIX, (const bf16*)(ws + WS_GT) + (size_t)l * 16 * 2 * 4096, a.in[2] + (size_t)l * 4096, a.in[3] + (size_t)l * 1024,
                        a.in[5] + (size_t)l * 1024, a.in[7] + (size_t)l * 1024, a.in[8] + (size_t)l * 1024, masks, (unsigned long long*)(ws + WS_SUM), tid);
#endif
#ifndef NO_ATTN
            for (int p = (G % 8 == 0) ? (int)(blockIdx.x % 8) * (G / 8) + (int)(blockIdx.x / 8) : (int)blockIdx.x; p < 256; p += G) { const int bh = p >> 3, s = p & 7, b = bh >> 3, h = bh & 7;
                const float sl2 = ex2(-(float)(h + 1)) * LOG2E;
                attn_unit(lds, PROJ, MIX, b, h, 15 - s, lam, sl2, a.in[13] + (size_t)l * 128, 1.0f - lam_init, tid);
                attn_unit(lds, PROJ, MIX, b, h, s, lam, sl2, a.in[13] + (size_t)l * 128, 1.0f - lam_init, tid); }
#endif
            if (l == 0) fold_phase(a, G, tid);
        }
#ifdef REP_MASK
        }
#endif
    }
#ifdef REP_SYNC
    for (int i = 0; i < REP_SYNC; ++i) xcd_barrier(xbar, (int)threadIdx.x);
#endif
}

extern "C" void kernel_launch(void* const* d_in, const int* in_sizes, int n_in, void* d_out, int out_size, void* d_ws, size_t ws_size, hipStream_t stream) {
    static int grid = 0;
    if (grid == 0) {
        if (n_in != 23 || in_sizes[0] != T * D || out_size != T * D || ws_size < WS_END) { fprintf(stderr, "kernel_launch: unexpected shapes (n_in %d, in0 %d, out %d, ws %zu)\n", n_in, n_in > 0 ? in_sizes[0] : -1, out_size, ws_size); grid = -1; return; }
        int dev = 0, cus = 0, per_cu = 0;
        hipGetDevice(&dev); hipDeviceGetAttribute(&cus, hipDeviceAttributeMultiprocessorCount, dev);
        if (hipFuncSetAttribute((const void*)fwd_kernel, hipFuncAttributeMaxDynamicSharedMemorySize, LDS_BYTES) != hipSuccess) { fprintf(stderr, "kernel_launch: hipFuncSetAttribute failed\n"); grid = -1; return; }
        if (hipOccupancyMaxActiveBlocksPerMultiprocessor(&per_cu, (const void*)fwd_kernel, 512, LDS_BYTES) != hipSuccess || per_cu < 1) { fprintf(stderr, "kernel_launch: occupancy query failed (%d)\n", per_cu); per_cu = 1; }
        (void)hipGetLastError();
        grid = cus * per_cu;
        fprintf(stderr, "kernel_launch: grid %d (cus %d x %d)\n", grid, cus, per_cu);
    }
    if (grid < 0) return;
    hipMemsetAsync((char*)d_ws + WS_CTL, 0, CTL_BYTES, stream);
    Args a{};
    for (int i = 0; i < 23; ++i) a.in[i] = (const float*)d_in[i];
    a.out = (float*)d_out; a.ws = (unsigned char*)d_ws;
#ifndef MK_SPLIT
    a.ph_lo = 0; a.ph_hi = NPHASE;
    void* args[] = {&a};
    hipError_t e = hipLaunchCooperativeKernel((const void*)fwd_kernel, dim3(grid), dim3(512), args, LDS_BYTES, stream);
    if (e != hipSuccess) fprintf(stderr, "cooperative launch failed: %s (grid %d)\n", hipGetErrorString(e), grid);
#else
    for (int ph = 0; ph < NPHASE; ++ph) { a.ph_lo = ph; a.ph_hi = ph + 1; void* args[] = {&a};
        hipError_t e = hipLaunchCooperativeKernel((const void*)fwd_kernel, dim3(grid), dim3(512), args, LDS_BYTES, stream);
        if (e != hipSuccess) { fprintf(stderr, "cooperative launch %d failed: %s (grid %d)\n", ph, hipGetErrorString(e), grid); break; } }
#endif
}
```
